# Optimizing an MI355X kernel written in HIP

```python
import jax, jax.numpy as jnp
from jax import lax
import numpy as np

D_MODEL = 1024
BATCH = 2
SEQ = 8192
DEPTH = 4
DEC_BATCH = 32
DEC_SEQ = 64
PAST_LEN = 4096

CHUNK = 64
N_EVEN = DEPTH - DEPTH // 2
N_ODD = DEPTH // 2
A_HEADS = 8
A_HEAD_DIM = D_MODEL // 16
A_WIDTH = A_HEADS * A_HEAD_DIM
A_BLOCK = 128
POOL_WINDOWS = (2, 4, 8, 16)
B_GROUPS = len(POOL_WINDOWS)
B_GROUP_DIM = D_MODEL // 8
B_WIDTH = B_GROUPS * B_GROUP_DIM
POOL_HIST = max(POOL_WINDOWS) - 1
C_WIDTH = D_MODEL // 2
C_KERNEL = 31
D_WIDTH = D_MODEL // 2
D_KERNEL = 3
EVEN_IN = 2 * A_WIDTH + B_WIDTH
ODD_IN = 2 * C_WIDTH + 3 * D_WIDTH
MIX_WIDTH = A_WIDTH + B_WIDTH
D_FF = 4 * D_MODEL
EPS = 1e-6

kernel_name = "hybrid_chunkmlp_pool_conformer_shortconv_step"


def rms_norm(x, g):
    xf = x.astype(jnp.float32)
    y = xf * lax.rsqrt(jnp.mean(xf * xf, axis=-1, keepdims=True) + EPS)
    return (y * g.astype(jnp.float32)).astype(x.dtype)


def layer_norm(x, g, b):
    xf = x.astype(jnp.float32)
    mu = jnp.mean(xf, axis=-1, keepdims=True)
    xc = xf - mu
    y = xc * lax.rsqrt(jnp.mean(xc * xc, axis=-1, keepdims=True) + EPS)
    return (y * g.astype(jnp.float32) + b.astype(jnp.float32)).astype(x.dtype)


def causal_dwconv(x_ext, w):
    c = w.shape[1]
    return lax.conv_general_dilated(
        x_ext, w[:, None, :].astype(x_ext.dtype), window_strides=(1,), padding="VALID",
        dimension_numbers=("NWC", "WIO", "NWC"), feature_group_count=c)


def chunk_gating(u, v, w_s, b_s):
    n, t = v.shape[0], v.shape[1]
    nb = -(-t // A_BLOCK)
    pad = nb * A_BLOCK - t
    vp = jnp.pad(v, ((0, 0), (0, pad), (0, 0), (0, 0))).reshape(n, nb, A_BLOCK, A_HEADS, A_HEAD_DIM)
    cidx = jnp.arange(A_BLOCK) // CHUNK
    mask = (cidx[None, :] <= cidx[:, None]).astype(w_s.dtype)
    mixed = jnp.einsum("hij,nbjhc->nbihc", w_s * mask[None], vp)
    mixed = mixed + b_s.T[None, None, :, :, None]
    mixed = mixed.reshape(n, nb * A_BLOCK, A_HEADS, A_HEAD_DIM)[:, :t]
    return u * mixed


def multiscale_pool(xb_ext, pos0):
    n, te, _ = xb_ext.shape
    t = te - POOL_HIST
    xf = xb_ext.astype(jnp.float32)
    csum = jnp.concatenate([jnp.zeros((n, 1, B_WIDTH), jnp.float32), jnp.cumsum(xf, axis=1)], axis=1)
    pos = pos0 + jnp.arange(t)
    outs = []
    for g, w in enumerate(POOL_WINDOWS):
        cg = csum[..., g * B_GROUP_DIM:(g + 1) * B_GROUP_DIM]
        end = cg[:, POOL_HIST + 1:POOL_HIST + 1 + t]
        start = cg[:, POOL_HIST + 1 - w:POOL_HIST + 1 - w + t]
        cnt = jnp.minimum(w, pos + 1).astype(jnp.float32)[None, :, None]
        outs.append((end - start) / cnt)
    return jnp.concatenate(outs, axis=-1) - xf[:, POOL_HIST:]


def even_mixer(h, pos0, hist_pool, w_in, w_out, a_w_s, a_b_s, a_ln_g, a_ln_b, b_pool_w, b_scale):
    n, t, _ = h.shape
    z = h @ w_in
    a = jax.nn.gelu(z[..., :2 * A_WIDTH])
    u = a[..., :A_WIDTH]
    v = layer_norm(a[..., A_WIDTH:], a_ln_g, a_ln_b)
    ya = chunk_gating(u.reshape(n, t, A_HEADS, A_HEAD_DIM), v.reshape(n, t, A_HEADS, A_HEAD_DIM),
                      a_w_s, a_b_s).reshape(n, t, A_WIDTH)
    xb_ext = jnp.concatenate([hist_pool.astype(z.dtype), z[..., 2 * A_WIDTH:]], axis=1)
    pooled = multiscale_pool(xb_ext, pos0).astype(h.dtype).reshape(n, t, B_GROUPS, B_GROUP_DIM)
    yb = jnp.einsum("ntgc,gcd->ntgd", pooled, b_pool_w).reshape(n, t, B_WIDTH) * b_scale
    y = jnp.concatenate([ya, yb], axis=-1) @ w_out
    return y, v, xb_ext[:, -POOL_HIST:]


def odd_mixer(h, hist_c, hist_d, w_in, w_out, c_conv_w, c_conv_b, c_ln_g, c_ln_b, d_conv_w):
    z = h @ w_in
    c_in = z[..., :C_WIDTH] * jax.nn.sigmoid(z[..., C_WIDTH:2 * C_WIDTH])
    c_ext = jnp.concatenate([hist_c.astype(z.dtype), c_in], axis=1)
    c = causal_dwconv(c_ext, c_conv_w) + c_conv_b
    c = jax.nn.silu(layer_norm(c, c_ln_g, c_ln_b))
    o = 2 * C_WIDTH
    gate_b = z[..., o:o + D_WIDTH]
    gate_c = z[..., o + D_WIDTH:o + 2 * D_WIDTH]
    xt = z[..., o + 2 * D_WIDTH:]
    d_ext = jnp.concatenate([hist_d.astype(z.dtype), gate_c * xt], axis=1)
    d = gate_b * causal_dwconv(d_ext, d_conv_w)
    y = jnp.concatenate([c, d], axis=-1) @ w_out
    return y, c_ext[:, -(C_KERNEL - 1):], d_ext[:, -(D_KERNEL - 1):]


def trunk(x, pos0, hist_pool, hist_c, hist_d, norm_mix_g, norm_ffn_g, final_norm_g,
          w_in_even, w_out_even, a_w_s, a_b_s, a_ln_g, a_ln_b, b_pool_w, b_scale,
          w_in_odd, w_out_odd, c_conv_w, c_conv_b, c_ln_g, c_ln_b, d_conv_w, w_ff1, w_ff2):
    vs, pools, cs, ds = [], [], [], []
    for layer in range(DEPTH):
        i = layer // 2
        h = rms_norm(x, norm_mix_g[layer])
        if layer % 2 == 0:
            y, v_rows, pool_rows = even_mixer(h, pos0, hist_pool[i], w_in_even[i], w_out_even[i],
                                              a_w_s[i], a_b_s[i], a_ln_g[i], a_ln_b[i],
                                              b_pool_w[i], b_scale[i])
            vs.append(v_rows)
            pools.append(pool_rows)
        else:
            y, c_rows, d_rows = odd_mixer(h, hist_c[i], hist_d[i], w_in_odd[i], w_out_odd[i],
                                          c_conv_w[i], c_conv_b[i], c_ln_g[i], c_ln_b[i], d_conv_w[i])
            cs.append(c_rows)
            ds.append(d_rows)
        x = x + y
        h = rms_norm(x, norm_ffn_g[layer])
        x = x + jnp.square(jax.nn.relu(h @ w_ff1[layer])) @ w_ff2[layer]
    return rms_norm(x, final_norm_g), jnp.stack(vs), jnp.stack(pools), jnp.stack(cs), jnp.stack(ds)


def setup_inputs(seed: int = 0) -> dict:
    key = jax.random.key(seed)
    ks = jax.random.split(key, 32)
    f32 = jnp.float32

    def nrm(k, shape, scale):
        return jax.random.normal(k, shape, f32) * scale

    return {
        "x_prompt": nrm(ks[0], (BATCH, SEQ, D_MODEL), 1.0),
        "x_sample": nrm(ks[1], (DEC_BATCH, DEC_SEQ, D_MODEL), 1.0),
        "state_pool": nrm(ks[2], (N_EVEN, DEC_BATCH, POOL_HIST, B_WIDTH), 1.0),
        "state_conv_c": nrm(ks[3], (N_ODD, DEC_BATCH, C_KERNEL - 1, C_WIDTH), 0.5),
        "state_conv_d": nrm(ks[4], (N_ODD, DEC_BATCH, D_KERNEL - 1, D_WIDTH), 1.0),
        "norm_mix_g": 1.0 + nrm(ks[5], (DEPTH, D_MODEL), 0.05),
        "norm_ffn_g": 1.0 + nrm(ks[6], (DEPTH, D_MODEL), 0.05),
        "final_norm_g": 1.0 + nrm(ks[7], (D_MODEL,), 0.05),
        "w_in_even": nrm(ks[8], (N_EVEN, D_MODEL, EVEN_IN), D_MODEL ** -0.5),
        "w_out_even": nrm(ks[9], (N_EVEN, MIX_WIDTH, D_MODEL), 0.5 * MIX_WIDTH ** -0.5),
        "a_w_s": nrm(ks[10], (N_EVEN, A_HEADS, A_BLOCK, A_BLOCK), A_BLOCK ** -0.5),
        "a_b_s": 1.0 + nrm(ks[11], (N_EVEN, A_HEADS, A_BLOCK), 0.05),
        "a_ln_g": 1.0 + nrm(ks[12], (N_EVEN, A_WIDTH), 0.05),
        "a_ln_b": nrm(ks[13], (N_EVEN, A_WIDTH), 0.02),
        "b_pool_w": nrm(ks[14], (N_EVEN, B_GROUPS, B_GROUP_DIM, B_GROUP_DIM), B_GROUP_DIM ** -0.5),
        "b_scale": 1.0 + nrm(ks[15], (N_EVEN, B_WIDTH), 0.1),
        "w_in_odd": nrm(ks[16], (N_ODD, D_MODEL, ODD_IN), D_MODEL ** -0.5),
        "w_out_odd": nrm(ks[17], (N_ODD, MIX_WIDTH, D_MODEL), 0.5 * MIX_WIDTH ** -0.5),
        "c_conv_w": nrm(ks[18], (N_ODD, C_KERNEL, C_WIDTH), C_KERNEL ** -0.5),
        "c_conv_b": nrm(ks[19], (N_ODD, C_WIDTH), 0.02),
        "c_ln_g": 1.0 + nrm(ks[20], (N_ODD, C_WIDTH), 0.05),
        "c_ln_b": nrm(ks[21], (N_ODD, C_WIDTH), 0.02),
        "d_conv_w": nrm(ks[22], (N_ODD, D_KERNEL, D_WIDTH), D_KERNEL ** -0.5),
        "w_ff1": nrm(ks[23], (DEPTH, D_MODEL, D_FF), D_MODEL ** -0.5),
        "w_ff2": nrm(ks[24], (DEPTH, D_FF, D_MODEL), 0.5 * D_FF ** -0.5),
    }


def reference(x_prompt, x_sample, state_pool, state_conv_c, state_conv_d,
              norm_mix_g, norm_ffn_g, final_norm_g,
              w_in_even, w_out_even, a_w_s, a_b_s, a_ln_g, a_ln_b, b_pool_w, b_scale,
              w_in_odd, w_out_odd, c_conv_w, c_conv_b, c_ln_g, c_ln_b, d_conv_w, w_ff1, w_ff2):
    nb = x_prompt.shape[0]
    dt = x_prompt.dtype
    zero_pool = jnp.zeros((N_EVEN, nb, POOL_HIST, B_WIDTH), dt)
    zero_c = jnp.zeros((N_ODD, nb, C_KERNEL - 1, C_WIDTH), dt)
    zero_d = jnp.zeros((N_ODD, nb, D_KERNEL - 1, D_WIDTH), dt)
    y_prompt, _, new_pool_p, new_conv_c_p, new_conv_d_p = trunk(
        x_prompt, 0, zero_pool, zero_c, zero_d, norm_mix_g, norm_ffn_g, final_norm_g,
        w_in_even, w_out_even, a_w_s, a_b_s, a_ln_g, a_ln_b, b_pool_w, b_scale,
        w_in_odd, w_out_odd, c_conv_w, c_conv_b, c_ln_g, c_ln_b, d_conv_w, w_ff1, w_ff2)
    y_sample, new_a_v_s, new_pool_s, new_conv_c_s, new_conv_d_s = trunk(
        x_sample, PAST_LEN, state_pool, state_conv_c, state_conv_d, norm_mix_g, norm_ffn_g, final_norm_g,
        w_in_even, w_out_even, a_w_s, a_b_s, a_ln_g, a_ln_b, b_pool_w, b_scale,
        w_in_odd, w_out_odd, c_conv_w, c_conv_b, c_ln_g, c_ln_b, d_conv_w, w_ff1, w_ff2)
    return (y_prompt, y_sample, new_pool_p, new_conv_c_p, new_conv_d_p,
            new_a_v_s, new_pool_s, new_conv_c_s, new_conv_d_s)
```

```cpp
#include <hip/hip_runtime.h>
#include <hip/hip_cooperative_groups.h>
#include <cstdio>
#include <cstdint>
#ifndef PROBE_SYNC2
#define PROBE_SYNC2 0
#define PROBE_MIX2 0
#define PROBE_CVT2 0
#define PROBE_FF1X2 0
#define PROBE_IN2 0
#define PROBE_OUT2 0
#define PROBE_FF2X2 0
#endif
namespace pg8 {
#define PG8_LAS __attribute__((address_space(3)))
typedef unsigned short bf16_t;
typedef short bf16x8 __attribute__((ext_vector_type(8)));
typedef float f32x4 __attribute__((ext_vector_type(4)));
typedef unsigned u32x4 __attribute__((ext_vector_type(4)));
constexpr int BM = 256, BK = 64, HALF = 128, HTB = HALF * BK * 2  , STAGE_BYTES = 8 * HTB, NXCD = 8, WGM = 8;

__host__ __device__ __forceinline__ int lds_byte(int r, int c) { const int st = (r >> 4) * 2 + (c >> 5), rr = r & 15, cc = c & 31, ob = rr * 64 + cc * 2; return st * 1024 + (ob ^ (((ob >> 9) & 1) << 5)); }
__host__ __device__ __forceinline__ void stage_rc(int b, int& R, int& C) { const int st = b / 1024, sb = b % 1024, swz = sb ^ (((sb >> 9) & 1) << 5); R = (st >> 1) * 16 + swz / 64; C = (st & 1) * 32 + (swz % 64) / 2; }
__host__ __device__ __forceinline__ int perm32(int rho) { const int n = rho >> 4, i = rho & 15; return 8 * (i >> 2) + 4 * n + (i & 3); }

struct Unit { int pm, pn, kt0, nkt, split; };
struct Gemm { const bf16_t* A; const bf16_t* Bt; int M, N, K; };

template <int NN> struct StaticOrderT {
    static constexpr int nM = 72, nN = NN, nwg = nM * nN, nkt_unused = 0;
    int G, c, nkt;
    __host__ __device__ void init(int K, int G_, int c_) { G = G_; c = c_; nkt = K / BK; }
    __host__ __device__ static void tile_of(int L, Unit& u) {
        static_assert(nwg % NXCD == 0 && nM % WGM == 0, "order constants");
        const int q = nwg / NXCD, xcd = L % NXCD, off = L / NXCD, wgid = xcd * q + off;
        const int nig = WGM * nN, gid = wgid / nig, fm = gid * WGM;
        u.pm = fm + ((wgid % nig) % WGM); u.pn = (wgid % nig) / WGM; }
    __host__ __device__ bool next(int i, Unit& u) const {
        const int L = i * G + c; if (L >= nwg) return false;
        tile_of(L, u); u.kt0 = 0; u.nkt = nkt; u.split = -1; return true;
    }
    __device__ __forceinline__ void a_ready(const Unit&) const {}
    __device__ __forceinline__ void done(const Unit&) const {}
};
constexpr int NS = 4;
struct TailOrder256 : StaticOrderT<4> {
    __host__ __device__ bool next(int i, Unit& u) const {
        const bool has_tail = c < 32 * NS, tail_now = has_tail && i == 0, full_now = has_tail ? (i == 1) : (i == 0);
        if (!(tail_now || full_now)) return false;
        tile_of(tail_now ? 256 + c / NS : c, u);
        u.nkt = tail_now ? nkt / NS : nkt; u.split = tail_now ? c % NS : -1; u.kt0 = tail_now ? (c % NS) * (nkt / NS) : 0;
        return true;
    }
};
__device__ __forceinline__ unsigned cvt_pk_bf16(float lo, float hi) { unsigned r; asm volatile("v_cvt_pk_bf16_f32 %0, %1, %2" : "=v"(r) : "v"(lo), "v"(hi)); return r; }
typedef float f32x2 __attribute__((ext_vector_type(2)));
constexpr float NORM_EPS = 1e-6f;
constexpr size_t EPI_WS_XB = (size_t)26 << 20, EPI_WS_SS = (size_t)206 << 20, EPI_WS_PART = (size_t)218 << 20, EPI_WS_CNT = (size_t)250 << 20;
typedef float f32x2e __attribute__((ext_vector_type(2)));
__device__ __forceinline__ float gelu_tanh(float v) {
    const float z = v * (1.0f + 0.044715f * v * v) * (-1.5957691216f * 1.4426950409f);
    return v * __builtin_amdgcn_rcpf(1.0f + __builtin_amdgcn_exp2f(z));
}
__device__ __forceinline__ float sigm(float g) { return __builtin_amdgcn_rcpf(1.0f + __builtin_amdgcn_exp2f(g * -1.4426950409f)); }
__device__ __forceinline__ float row_rstd(const float* ss, int row, int fq) {
    const f32x4 sp = *(const f32x4*)(ss + (size_t)row * 16 + fq * 4); float sr = (sp[0] + sp[1]) + (sp[2] + sp[3]); sr += __shfl_xor(sr, 16); sr += __shfl_xor(sr, 32);
    return __builtin_amdgcn_rsqf(sr * (1.0f / 1024.0f) + NORM_EPS);
}
__device__ __forceinline__ void row_rstd8(const float* ss, int row0, int fq, float (&rs)[2][4]) {
    f32x4 sp[2][4];
#pragma unroll
    for (int ai = 0; ai < 2; ++ai)
#pragma unroll
        for (int m = 0; m < 4; ++m) sp[ai][m] = *(const f32x4*)(ss + (size_t)(row0 + ai * HALF + m * 16) * 16 + fq * 4);
    asm volatile("" ::: "memory");
#pragma unroll
    for (int ai = 0; ai < 2; ++ai)
#pragma unroll
        for (int m = 0; m < 4; ++m) { float sr = (sp[ai][m][0] + sp[ai][m][1]) + (sp[ai][m][2] + sp[ai][m][3]); sr += __shfl_xor(sr, 16); sr += __shfl_xor(sr, 32);
            rs[ai][m] = __builtin_amdgcn_rsqf(sr * (1.0f / 1024.0f) + NORM_EPS); }
}
template <int MODE> struct EpiAct {
    static constexpr bool PERM = true, AFTER_DRAIN = false;
    bf16_t* O; int ldc; const float* ss; float* vst;
    __device__ __forceinline__ void operator()(f32x4 (&acc)[2][2][4][2], const Unit& u, int wr, int wc, int fr_, int fq_, int wid, int lane_) const {
        int fr = fr_, fq = fq_, lane = lane_; asm volatile("" : "+v"(fr), "+v"(fq), "+v"(lane));
        const int row0 = u.pm * BM + wr * 64 + fr, col0 = u.pn * BM + wc * 32 + 8 * fq;
        const bool act = (MODE == 0) && (u.pn < 4); const bool st = (MODE == 0) && (u.pn == 2 || u.pn == 3);
        float rsv[2][4]; row_rstd8(ss, row0, fq, rsv);
#pragma unroll
        for (int ai = 0; ai < 2; ++ai)
#pragma unroll
            for (int m = 0; m < 4; ++m) { const int row = row0 + ai * HALF + m * 16; const float rs = rsv[ai][m];
                bf16_t* rowp = O + (size_t)row * ldc + col0; float s1 = 0.f, s2 = 0.f;
#pragma unroll
                for (int bj = 0; bj < 2; ++bj) { f32x4 v0 = acc[ai][bj][m][0] * rs, v1 = acc[ai][bj][m][1] * rs;
                    if (MODE == 0) { if (act) {
#pragma unroll
                        for (int e = 0; e < 4; ++e) { v0[e] = gelu_tanh(v0[e]); v1[e] = gelu_tanh(v1[e]); } }
                        if (st) { s1 += (v0[0] + v0[1]) + (v0[2] + v0[3]) + (v1[0] + v1[1]) + (v1[2] + v1[3]);
                                  s2 += (v0[0] * v0[0] + v0[1] * v0[1]) + (v0[2] * v0[2] + v0[3] * v0[3]) + (v1[0] * v1[0] + v1[1] * v1[1]) + (v1[2] * v1[2] + v1[3] * v1[3]); } }
                    if (MODE == 2) {
#pragma unroll
                        for (int e = 0; e < 4; ++e) { const float a = fmaxf(v0[e], 0.f), b = fmaxf(v1[e], 0.f); v0[e] = a * a; v1[e] = b * b; } }
                    u32x4 w; w.x = cvt_pk_bf16(v0[0], v0[1]); w.y = cvt_pk_bf16(v0[2], v0[3]); w.z = cvt_pk_bf16(v1[0], v1[1]); w.w = cvt_pk_bf16(v1[2], v1[3]);
                    *(u32x4*)(rowp + bj * HALF) = w; }
                if (MODE == 0) { if (st) { s1 += __shfl_xor(s1, 16); s1 += __shfl_xor(s1, 32); s2 += __shfl_xor(s2, 16); s2 += __shfl_xor(s2, 32);
                    if (fq == 0) *(f32x2e*)(vst + (size_t)row * 16 + ((u.pn - 2) * 4 + wc) * 2) = (f32x2e){s1, s2}; } } }
    }
};
struct EpiOdd {
    static constexpr bool PERM = true, AFTER_DRAIN = false;
    bf16_t* O; const float* ss;
    __device__ __forceinline__ void operator()(f32x4 (&acc)[2][2][4][2], const Unit& u, int wr, int wc, int fr_, int fq_, int wid, int lane_) const {
        int fr = fr_, fq = fq_, lane = lane_; asm volatile("" : "+v"(fr), "+v"(fq), "+v"(lane));
        const int row0 = u.pm * BM + wr * 64 + fr, cin = wc * 32 + 8 * fq;
        const int mode = u.pn < 4 ? 0 : (u.pn < 8 ? 1 : 2);
        const int cbase = mode == 0 ? 128 * u.pn : (mode == 1 ? 1024 + 128 * (u.pn - 4) : 512 + 256 * (u.pn - 8));
        float rsv[2][4]; row_rstd8(ss, row0, fq, rsv);
#pragma unroll
        for (int ai = 0; ai < 2; ++ai)
#pragma unroll
            for (int m = 0; m < 4; ++m) { const int row = row0 + ai * HALF + m * 16; const float rs = rsv[ai][m];
                bf16_t* rowp = O + (size_t)row * 1536 + cbase + cin;
                f32x4 a0 = acc[ai][0][m][0] * rs, a1 = acc[ai][0][m][1] * rs, b0 = acc[ai][1][m][0] * rs, b1 = acc[ai][1][m][1] * rs;
                if (mode == 2) {
                    u32x4 w; w.x = cvt_pk_bf16(a0[0], a0[1]); w.y = cvt_pk_bf16(a0[2], a0[3]); w.z = cvt_pk_bf16(a1[0], a1[1]); w.w = cvt_pk_bf16(a1[2], a1[3]); *(u32x4*)rowp = w;
                    u32x4 x; x.x = cvt_pk_bf16(b0[0], b0[1]); x.y = cvt_pk_bf16(b0[2], b0[3]); x.z = cvt_pk_bf16(b1[0], b1[1]); x.w = cvt_pk_bf16(b1[2], b1[3]); *(u32x4*)(rowp + HALF) = x;
                } else {
                    if (mode == 0) {
#pragma unroll
                        for (int e = 0; e < 4; ++e) { b0[e] = sigm(b0[e]); b1[e] = sigm(b1[e]); } }
                    a0 = a0 * b0; a1 = a1 * b1;
                    u32x4 w; w.x = cvt_pk_bf16(a0[0], a0[1]); w.y = cvt_pk_bf16(a0[2], a0[3]); w.z = cvt_pk_bf16(a1[0], a1[1]); w.w = cvt_pk_bf16(a1[2], a1[3]); *(u32x4*)rowp = w;
                } }
    }
};
struct EpiRes {
    static constexpr bool PERM = true, AFTER_DRAIN = false;
    float* X; unsigned char* wsb; int use;
#if PROBE_OUT2 || PROBE_FF2X2
    int dry;
#endif
    __device__ __forceinline__ void operator()(f32x4 (&acc)[2][2][4][2], const Unit& u, int wr, int wc, int fr_, int fq_, int wid, int lane_) const {
        int fr = fr_, fq = fq_, lane = lane_; asm volatile("" : "+v"(fr), "+v"(fq), "+v"(lane));
#if PROBE_OUT2 || PROBE_FF2X2
        if (dry) return;
#endif
        if (u.split >= 0) {
            typedef unsigned long long u64;
            const int s = u.split, tt = (int)blockIdx.x / NS; float* part = (float*)(wsb + EPI_WS_PART); unsigned* cnt = (unsigned*)(wsb + EPI_WS_CNT) + use * 256 + tt * 8 + wid;
            u64* P = (u64*)(part + (((size_t)tt * NS + s) * 8 + wid) * 8192) + lane * 2;
#pragma unroll
            for (int q = 0; q < 4; ++q) if (q != s) {
#pragma unroll
                for (int mm = 0; mm < 2; ++mm)
#pragma unroll
                    for (int bj = 0; bj < 2; ++bj)
#pragma unroll
                        for (int n = 0; n < 2; ++n) { const f32x4 v = acc[q >> 1][bj][2 * (q & 1) + mm][n]; u64* p = P + (q * 8 + (mm * 2 + bj) * 2 + n) * 128;
                            __hip_atomic_store(p, ((u64)__float_as_uint(v[1]) << 32) | __float_as_uint(v[0]), __ATOMIC_RELAXED, __HIP_MEMORY_SCOPE_AGENT);
                            __hip_atomic_store(p + 1, ((u64)__float_as_uint(v[3]) << 32) | __float_as_uint(v[2]), __ATOMIC_RELAXED, __HIP_MEMORY_SCOPE_AGENT); } }
            asm volatile("s_waitcnt vmcnt(0)" ::: "memory");
            if (lane == 0) (void)__hip_atomic_fetch_add(cnt, 1u, __ATOMIC_RELAXED, __HIP_MEMORY_SCOPE_AGENT);
            { unsigned spins = 0;
              while ((unsigned)__builtin_amdgcn_readfirstlane((int)__hip_atomic_load(cnt, __ATOMIC_RELAXED, __HIP_MEMORY_SCOPE_AGENT)) < (unsigned)NS) { __builtin_amdgcn_s_sleep(2); if (++spins > (1u << 22)) break; } }
#pragma unroll
            for (int q = 0; q < 4; ++q) if (q == s) {
#pragma unroll
                for (int mm = 0; mm < 2; ++mm)
#pragma unroll
                    for (int bj = 0; bj < 2; ++bj)
#pragma unroll
                        for (int n = 0; n < 2; ++n) { const int ro = (q * 8 + (mm * 2 + bj) * 2 + n) * 128; f32x4 sum = (f32x4){0.f, 0.f, 0.f, 0.f};
#pragma unroll
                            for (int sp = 0; sp < NS; ++sp) {
                                if (sp == s) sum += acc[q >> 1][bj][2 * (q & 1) + mm][n];
                                else { const u64* qp = (const u64*)(part + (((size_t)tt * NS + sp) * 8 + wid) * 8192) + lane * 2 + ro;
                                    const u64 lo = __hip_atomic_load(qp, __ATOMIC_RELAXED, __HIP_MEMORY_SCOPE_AGENT), hi = __hip_atomic_load(qp + 1, __ATOMIC_RELAXED, __HIP_MEMORY_SCOPE_AGENT);
                                    sum += (f32x4){__uint_as_float((unsigned)lo), __uint_as_float((unsigned)(lo >> 32)), __uint_as_float((unsigned)hi), __uint_as_float((unsigned)(hi >> 32))}; } }
                            acc[q >> 1][bj][2 * (q & 1) + mm][n] = sum; } }
        }
        const int row0 = u.pm * BM + wr * 64 + fr, col0 = u.pn * BM + wc * 32 + 8 * fq;
        bf16_t* XB = (bf16_t*)(wsb + EPI_WS_XB); float* ssout = (float*)(wsb + EPI_WS_SS) + (size_t)(use + 1) * (18432 * 16);
        const float* xsrc = X - (u.pm < 64 ? 0 : (size_t)16384 * 1024) * 0;
        if (use == 0) { typedef const float* const __attribute__((address_space(4)))* KP; const KP ka = (KP)__builtin_amdgcn_kernarg_segment_ptr(); xsrc = (u.pm < 64) ? ka[0] : ka[1] - (size_t)16384 * 1024; }
#pragma unroll
        for (int ai = 0; ai < 2; ++ai)
#pragma unroll
            for (int m = 0; m < 4; ++m) { if (u.split >= 0 && (ai * 2 + (m >> 1)) != u.split) continue;
                const int row = row0 + ai * HALF + m * 16; float sq = 0.f;
                float* xp = X + (size_t)row * 1024 + col0; bf16_t* bp = XB + (size_t)row * 1024 + col0;
                const float* sp_ = xsrc + (size_t)row * 1024 + col0;
#pragma unroll
                for (int bj = 0; bj < 2; ++bj) { const f32x4 x0 = *(const f32x4*)(sp_ + bj * HALF) + acc[ai][bj][m][0], x1 = *(const f32x4*)(sp_ + bj * HALF + 4) + acc[ai][bj][m][1];
                    *(f32x4*)(xp + bj * HALF) = x0; *(f32x4*)(xp + bj * HALF + 4) = x1;
                    sq += (x0[0] * x0[0] + x0[1] * x0[1]) + (x0[2] * x0[2] + x0[3] * x0[3]) + (x1[0] * x1[0] + x1[1] * x1[1]) + (x1[2] * x1[2] + x1[3] * x1[3]);
                    u32x4 w; w.x = cvt_pk_bf16(x0[0], x0[1]); w.y = cvt_pk_bf16(x0[2], x0[3]); w.z = cvt_pk_bf16(x1[0], x1[1]); w.w = cvt_pk_bf16(x1[2], x1[3]);
                    if (use != 7) *(u32x4*)(bp + bj * HALF) = w; }
                sq += __shfl_xor(sq, 16); sq += __shfl_xor(sq, 32);
                if (fq == 0) ssout[(size_t)row * 16 + u.pn * 4 + wc] = sq;
                if (m == 3) asm volatile("" ::: "memory"); }
    }
};

template <class Epi, class Sched, bool ALIGN_EPI = false, bool SP2 = false>
__device__ __forceinline__ void gemm_phase(PG8_LAS unsigned char* lds, const Gemm g, const Sched& S, const Epi& E, const int tid_in) {
    const int tid = tid_in, wid = __builtin_amdgcn_readfirstlane(tid >> 6), lane = tid & 63, wr = wid >> 2, wc = wid & 3, fr = lane & 15, fq = lane >> 4;
    const int K = g.K;
    unsigned voffA[2], voffB[2];
#pragma unroll
    for (int i = 0; i < 2; ++i) { int R, C; stage_rc(tid * 16 + i * 8192, R, C); const int Rb = Epi::PERM ? ((R & ~31) + perm32(R & 31)) : R;
        voffA[i] = (unsigned)(R * K + C) * 2u; voffB[i] = (unsigned)(Rb * K + C) * 2u; }
    const size_t kstep = (size_t)(BK * 2);
    const size_t hstep = (size_t)HALF * K * 2;
    const size_t tstep = 2 * hstep;
    const unsigned ldsw = (unsigned)wid * 1024u;
    const int aoff = lds_byte(wr * 64 + fr, fq * 8), boff = lds_byte(wc * 32 + fr, fq * 8);
#define PG8_SA(b, h) (((b) * 2 + (h)) * HTB)
#define PG8_SB(b, h) ((4 + (b) * 2 + (h)) * HTB)
#define PG8_STAGE(bufoff, gbase, voff) do { _Pragma("unroll") for (int _i = 0; _i < 2; ++_i) \
        __builtin_amdgcn_global_load_lds((const unsigned*)((const char*)(gbase) + (voff)[_i]), (PG8_LAS unsigned*)(lds + (bufoff) + ldsw + _i * 8192), 16, 0, 0); } while (0)
#define PG8_LDA(dst, b, h) do { _Pragma("unroll") for (int m = 0; m < 4; ++m) _Pragma("unroll") for (int k = 0; k < 2; ++k) dst[m][k] = *(const PG8_LAS bf16x8*)(lds + PG8_SA(b, h) + aoff + m * 2048 + k * 1024); } while (0)
#define PG8_LDB(dst, b, h) do { _Pragma("unroll") for (int n = 0; n < 2; ++n) _Pragma("unroll") for (int k = 0; k < 2; ++k) dst[n][k] = *(const PG8_LAS bf16x8*)(lds + PG8_SB(b, h) + boff + n * 2048 + k * 1024); } while (0)
#define PG8_MMA(ai, bj, At, Bt) do { __builtin_amdgcn_s_setprio(1); _Pragma("unroll") for (int m = 0; m < 4; ++m) _Pragma("unroll") for (int n = 0; n < 2; ++n) _Pragma("unroll") for (int k = 0; k < 2; ++k) \
        acc[ai][bj][m][n] = __builtin_amdgcn_mfma_f32_16x16x32_bf16(Bt[n][k], At[m][k], acc[ai][bj][m][n], 0, 0, 0); __builtin_amdgcn_s_setprio(0); } while (0)
#define PG8_WAIT_V(n) asm volatile("s_waitcnt vmcnt(" #n ")" ::: "memory")
#define PG8_WAIT_L(n) asm volatile("s_waitcnt lgkmcnt(" #n ")" ::: "memory")
#define PG8_BAR __builtin_amdgcn_s_barrier()
#define PG8_SCHED __builtin_amdgcn_sched_barrier(0)
    Unit cur, nxt; int ui = 0;
    if (!S.next(0, cur)) return;
    f32x4 acc[2][2][4][2];
#pragma unroll
    for (int a = 0; a < 2; ++a)
#pragma unroll
        for (int b = 0; b < 2; ++b)
#pragma unroll
            for (int m = 0; m < 4; ++m)
#pragma unroll
                for (int n = 0; n < 2; ++n) acc[a][b][m][n] = (f32x4){0.f, 0.f, 0.f, 0.f};
    bf16x8 At[4][2], B0[2][2], B1[2][2];
    const char* cA = (const char*)g.A + (size_t)cur.pm * tstep + (size_t)cur.kt0 * kstep; const char* cB = (const char*)g.Bt + (size_t)cur.pn * tstep + (size_t)cur.kt0 * kstep;
    S.a_ready(cur);
    if constexpr (SP2) {
        PG8_STAGE(PG8_SB(0, 0), cB, voffB); PG8_STAGE(PG8_SB(0, 1), cB + hstep, voffB); PG8_STAGE(PG8_SA(0, 0), cA, voffA); PG8_STAGE(PG8_SA(0, 1), cA + hstep, voffA);
        if (wr == 1) PG8_BAR;
        PG8_WAIT_V(2); PG8_BAR;
        PG8_STAGE(PG8_SB(1, 0), cB + kstep, voffB); PG8_STAGE(PG8_SA(1, 0), cA + kstep, voffA); PG8_STAGE(PG8_SB(1, 1), cB + hstep + kstep, voffB);
        PG8_WAIT_V(6); PG8_BAR;
    } else {
        PG8_STAGE(PG8_SB(0, 0), cB, voffB); PG8_STAGE(PG8_SA(0, 0), cA, voffA); PG8_STAGE(PG8_SB(0, 1), cB + hstep, voffB); PG8_STAGE(PG8_SA(0, 1), cA + hstep, voffA);
        if (wr == 1) PG8_BAR;
        PG8_WAIT_V(4); PG8_BAR;
        PG8_STAGE(PG8_SB(1, 0), cB + kstep, voffB); PG8_STAGE(PG8_SA(1, 0), cA + kstep, voffA); PG8_STAGE(PG8_SB(1, 1), cB + hstep + kstep, voffB);
        PG8_WAIT_V(6); PG8_BAR;
    }
    for (;;) {
        const bool has_next = S.next(ui + 1, nxt);
        const char* nA = has_next ? (const char*)g.A + (size_t)nxt.pm * tstep + (size_t)nxt.kt0 * kstep : cA; const char* nB = has_next ? (const char*)g.Bt + (size_t)nxt.pn * tstep + (size_t)nxt.kt0 * kstep : cB;
        const int nt = cur.nkt;
        for (int t = 0; t < nt; t += 2) {
            const bool last = (t == nt - 2);
            const char* a1 = cA + (size_t)(t + 1) * kstep;
            const char* a2 = last ? nA : cA + (size_t)(t + 2) * kstep; const char* b2 = last ? nB : cB + (size_t)(t + 2) * kstep;
            const char* a3 = a2 + kstep; const char* b3 = b2 + kstep;
            if (last && has_next) S.a_ready(nxt);
            if constexpr (SP2) {
            PG8_LDB(B0, 0, 0); PG8_LDB(B1, 0, 1); PG8_SCHED; PG8_LDA(At, 0, 0); PG8_STAGE(PG8_SA(1, 1), a1 + hstep, voffA);
            PG8_WAIT_V(8); PG8_WAIT_L(0); PG8_BAR; PG8_MMA(0, 0, At, B0); PG8_MMA(0, 1, At, B1); PG8_BAR; PG8_SCHED;
            PG8_LDA(At, 0, 1); PG8_STAGE(PG8_SB(0, 0), b2, voffB); PG8_STAGE(PG8_SB(0, 1), b2 + hstep, voffB); PG8_STAGE(PG8_SA(0, 0), a2, voffA);
            PG8_WAIT_V(8); PG8_WAIT_L(0); PG8_BAR; PG8_MMA(1, 0, At, B0); PG8_MMA(1, 1, At, B1); PG8_BAR; PG8_SCHED;
            PG8_LDB(B0, 1, 0); PG8_LDB(B1, 1, 1); PG8_SCHED; PG8_LDA(At, 1, 0); PG8_STAGE(PG8_SA(0, 1), a2 + hstep, voffA);
            PG8_WAIT_V(8); PG8_WAIT_L(0); PG8_BAR; PG8_MMA(0, 0, At, B0); PG8_MMA(0, 1, At, B1); PG8_BAR; PG8_SCHED;
            PG8_LDA(At, 1, 1); PG8_STAGE(PG8_SB(1, 0), b3, voffB); PG8_STAGE(PG8_SB(1, 1), b3 + hstep, voffB); PG8_STAGE(PG8_SA(1, 0), a3, voffA);
            PG8_WAIT_V(8); PG8_WAIT_L(0); PG8_BAR; PG8_MMA(1, 0, At, B0); PG8_MMA(1, 1, At, B1); PG8_BAR; PG8_SCHED;
            } else {
            PG8_LDB(B0, 0, 0); PG8_SCHED; PG8_LDA(At, 0, 0); PG8_STAGE(PG8_SA(1, 1), a1 + hstep, voffA);
            PG8_WAIT_L(8); PG8_BAR; PG8_WAIT_L(0); PG8_MMA(0, 0, At, B0); PG8_BAR; PG8_SCHED;
            PG8_LDB(B1, 0, 1); PG8_STAGE(PG8_SB(0, 0), b2, voffB);
            PG8_BAR; PG8_WAIT_L(0); PG8_MMA(0, 1, At, B1); PG8_BAR;
            PG8_LDA(At, 0, 1); PG8_STAGE(PG8_SA(0, 0), a2, voffA);
            PG8_BAR; PG8_WAIT_L(0); PG8_MMA(1, 0, At, B0); PG8_BAR; PG8_SCHED;
            PG8_STAGE(PG8_SB(0, 1), b2 + hstep, voffB);
            PG8_WAIT_V(6); PG8_BAR; PG8_MMA(1, 1, At, B1); PG8_BAR;
            PG8_LDB(B0, 1, 0); PG8_SCHED; PG8_LDA(At, 1, 0); PG8_STAGE(PG8_SA(0, 1), a2 + hstep, voffA);
            PG8_WAIT_L(8); PG8_BAR; PG8_WAIT_L(0); PG8_MMA(0, 0, At, B0); PG8_BAR; PG8_SCHED;
            PG8_LDB(B1, 1, 1); PG8_STAGE(PG8_SB(1, 0), b3, voffB);
            PG8_BAR; PG8_WAIT_L(0); PG8_MMA(0, 1, At, B1); PG8_BAR;
            PG8_LDA(At, 1, 1); PG8_STAGE(PG8_SA(1, 0), a3, voffA);
            PG8_BAR; PG8_WAIT_L(0); PG8_MMA(1, 0, At, B0); PG8_BAR; PG8_SCHED;
            PG8_STAGE(PG8_SB(1, 1), b3 + hstep, voffB);
            PG8_WAIT_V(6); PG8_BAR; PG8_MMA(1, 1, At, B1); PG8_BAR;
            }
        }
        if constexpr (ALIGN_EPI) { if (wr == 0) PG8_BAR; }
        if constexpr (!Epi::AFTER_DRAIN) { E(acc, cur, wr, wc, fr, fq, wid, lane); S.done(cur); }
        if (!has_next) break;
#pragma unroll
        for (int a = 0; a < 2; ++a)
#pragma unroll
            for (int b = 0; b < 2; ++b)
#pragma unroll
                for (int m = 0; m < 4; ++m)
#pragma unroll
                    for (int n = 0; n < 2; ++n) acc[a][b][m][n] = (f32x4){0.f, 0.f, 0.f, 0.f};
        cur = nxt; cA = nA; cB = nB; ++ui;
        if constexpr (ALIGN_EPI) { if (wr == 1) PG8_BAR; }
    }
    PG8_WAIT_V(0);
    if constexpr (!ALIGN_EPI) { if (wr == 0) PG8_BAR; }
    PG8_BAR;
    if constexpr (Epi::AFTER_DRAIN) { E.fused(acc, cur, wr, wc, fr, fq, lds, wid, lane); S.done(cur); }
#undef PG8_SA
#undef PG8_SB
#undef PG8_STAGE
#undef PG8_LDA
#undef PG8_LDB
#undef PG8_MMA
#undef PG8_WAIT_V
#undef PG8_WAIT_L
#undef PG8_BAR
#undef PG8_SCHED
}
}

namespace cg = cooperative_groups;
#define GAS __attribute__((address_space(1)))
#define LAS __attribute__((address_space(3)))
typedef unsigned short bf16;
typedef unsigned v4u __attribute__((ext_vector_type(4)));
typedef unsigned v2u __attribute__((ext_vector_type(2)));
typedef float f32x4 __attribute__((ext_vector_type(4)));
typedef float f32x2 __attribute__((ext_vector_type(2)));
typedef short bf16x8 __attribute__((ext_vector_type(8)));

constexpr int NWAVES = 8, NTHR = 512;
constexpr int D = 1024, MP = 16384, MS = 2048, M = MP + MS, FF = 4096, EVEN_IN = 1536, ODD_IN = 2560, SEQ = 8192;
constexpr float EPS = 1e-6f;
constexpr int LDS_BYTES = 147456;
constexpr size_t MiB = 1u << 20;
constexpr size_t WS_SS = 206 * MiB;
constexpr size_t WS_WIN = 1 * MiB;
constexpr size_t WS_WOUT = 6 * MiB;
constexpr size_t WS_WFF1 = 10 * MiB;
constexpr size_t WS_WFF2 = 18 * MiB;
constexpr size_t WS_XB = 26 * MiB;
constexpr size_t WS_H = 62 * MiB;
constexpr size_t WS_Z = WS_H;
constexpr size_t WS_MIX = 152 * MiB;
constexpr size_t WS_PART = 218 * MiB;
constexpr size_t WS_CNT = 250 * MiB;
constexpr size_t CNT_BYTES = 8 * 256 * 4;
constexpr size_t WS_BAR = WS_CNT + CNT_BYTES;
constexpr size_t ZERO_BYTES = 24576;
constexpr size_t WS_VST = 251 * MiB;
constexpr size_t WS_END = 253 * MiB;
static_assert(pg8::NS == 4, "partial buffer sized for 4 slices");
static_assert(pg8::EPI_WS_XB == WS_XB && pg8::EPI_WS_SS == WS_SS && pg8::EPI_WS_PART == WS_PART && pg8::EPI_WS_CNT == WS_CNT, "epilogue view of the d_ws map");
constexpr size_t O_Y = 0, O_POOL_P = (size_t)M * D, O_CC_P = O_POOL_P + 2 * 2 * 15 * 512, O_CD_P = O_CC_P + 2 * 2 * 30 * 512, O_AV_S = O_CD_P + 2 * 2 * 2 * 512,
                 O_POOL_S = O_AV_S + (size_t)2 * 32 * 64 * 512, O_CC_S = O_POOL_S + 2 * 32 * 15 * 512, O_CD_S = O_CC_S + 2 * 32 * 30 * 512, O_END = O_CD_S + 2 * 32 * 2 * 512;
static_assert(O_END == 22607872, "output size");

__device__ __forceinline__ float wave_sum(float v) {
#pragma unroll
    for (int o = 1; o < 64; o <<= 1) v += __shfl_xor(v, o);
    return v;
}
__device__ __forceinline__ unsigned pk2(float lo, float hi) { return pg8::cvt_pk_bf16(lo, hi); }
__device__ __forceinline__ float bflo(unsigned w) { return __uint_as_float(w << 16); }
__device__ __forceinline__ float bfhi(unsigned w) { return __uint_as_float(w & 0xffff0000u); }
__device__ __forceinline__ void unpack8(const v4u w, f32x4& a, f32x4& b) { a = (f32x4){bflo(w.x), bfhi(w.x), bflo(w.y), bfhi(w.y)}; b = (f32x4){bflo(w.z), bfhi(w.z), bflo(w.w), bfhi(w.w)}; }
__device__ __forceinline__ v4u pack8(const f32x4 a, const f32x4 b) { v4u w; w.x = pk2(a[0], a[1]); w.y = pk2(a[2], a[3]); w.z = pk2(b[0], b[1]); w.w = pk2(b[2], b[3]); return w; }
__device__ __forceinline__ float sigmoidf_(float g) { return __builtin_amdgcn_rcpf(1.0f + __builtin_amdgcn_exp2f(g * -1.4426950409f)); }

__device__ __forceinline__ int odd_src_col(int n0) { const int p = n0 >> 8, hf = (n0 >> 7) & 1, j = n0 & 127; return p < 4 ? hf * 512 + 128 * p + j : (p < 8 ? 1536 + hf * 512 + 128 * (p - 4) + j : 1024 + (n0 - 2048)); }
__device__ __forceinline__ void cvt_item(const float* W, int K, int N, const float* gk, bf16* WT, LAS float* scr, int item, int lane, bool remap = false) {
    const int nblk = N / 32, kb = item / nblk, nb = item % nblk, k0 = 64 * kb, n0 = 32 * nb, s0 = remap ? odd_src_col(n0) : n0;
#pragma unroll 1
    for (int hb = 0; hb < 2; ++hb) {
        float wv[16]; const float* wp = W + (size_t)(k0 + 32 * hb + (lane >> 5)) * N + s0 + (lane & 31);
#pragma unroll
        for (int i = 0; i < 16; ++i) wv[i] = wp[(size_t)(2 * i) * N];
#pragma unroll
        for (int i = 0; i < 16; ++i) { const int kk = 32 * hb + 2 * i + (lane >> 5); float w = wv[i]; if (gk) w *= gk[k0 + kk]; scr[kk * 33 + (lane & 31)] = w; }
    }
    asm volatile("s_waitcnt lgkmcnt(0)" ::: "memory");
    const int c = lane & 7;
#pragma unroll
    for (int j = 0; j < 4; ++j) { const int n = (lane >> 3) + 8 * j; const LAS float* s = scr + (8 * c) * 33 + n;
        v4u o; o.x = pk2(s[0 * 33], s[1 * 33]); o.y = pk2(s[2 * 33], s[3 * 33]); o.z = pk2(s[4 * 33], s[5 * 33]); o.w = pk2(s[6 * 33], s[7 * 33]);
        *(v4u*)(WT + (size_t)(n0 + n) * K + k0 + 8 * c) = o; }
    asm volatile("s_waitcnt lgkmcnt(0)" ::: "memory");
}
__device__ __forceinline__ void fold_item(const float* Wo, const float* pw, const float* bs, bf16* WT, LAS float* scr, int item, int lane) {
    const int nb = item & 31, ch = (item >> 5) & 1, g = item >> 6, n0 = nb * 32, c = ch * 64 + lane;
    { const int n = lane & 31, dh = lane >> 5; const float* wp = Wo + (size_t)(512 + g * 128 + dh) * 1024 + n0 + n; const float* sp = bs + g * 128 + dh;
#pragma unroll 1
      for (int b = 0; b < 4; ++b) { float wv[16], sv[16];
#pragma unroll
          for (int i = 0; i < 16; ++i) { wv[i] = wp[(size_t)(2 * (b * 16 + i)) * 1024]; sv[i] = sp[2 * (b * 16 + i)]; }
#pragma unroll
          for (int i = 0; i < 16; ++i) scr[(2 * (b * 16 + i) + dh) * 32 + n] = wv[i] * sv[i]; } }
    asm volatile("s_waitcnt lgkmcnt(0)" ::: "memory");
    f32x4 acc[8];
#pragma unroll
    for (int i = 0; i < 8; ++i) acc[i] = (f32x4){0.f, 0.f, 0.f, 0.f};
    const float* pr = pw + ((size_t)g * 128 + c) * 128;
#pragma unroll 1
    for (int d0 = 0; d0 < 128; d0 += 32) { f32x4 pv[8];
#pragma unroll
        for (int j = 0; j < 8; ++j) pv[j] = *(const f32x4*)(pr + d0 + 4 * j);
#pragma unroll
        for (int j = 0; j < 8; ++j)
#pragma unroll
            for (int dd = 0; dd < 4; ++dd)
#pragma unroll
                for (int n4 = 0; n4 < 8; ++n4) { const f32x4 w = *(const LAS f32x4*)(scr + (d0 + 4 * j + dd) * 32 + n4 * 4); acc[n4] += w * pv[j][dd]; } }
#pragma unroll
    for (int n4 = 0; n4 < 8; ++n4)
#pragma unroll
        for (int e = 0; e < 4; ++e) WT[(size_t)(n0 + n4 * 4 + e) * 1024 + 512 + g * 128 + c] = (bf16)(pk2(acc[n4][e], 0.f) & 0xffffu);
    asm volatile("s_waitcnt lgkmcnt(0)" ::: "memory");
}

struct Args { const float* in[25]; float* out; unsigned char* ws; };
typedef const __attribute__((address_space(4))) Args* CArgs;
#define LAUNDER_V(x) asm volatile("" : "+v"(x))
#define LAUNDER_S(x) asm volatile("" : "+s"(x))

__device__ __forceinline__ int cvt_count(int kind, int layer) {
    if (kind == 0) return (layer & 1) ? 16 * (ODD_IN / 32) : 16 * (EVEN_IN / 32);
    if (kind == 1) return (layer & 1) ? 16 * 32 : 8 * 32 + 256;
    if (kind == 2) return 16 * (FF / 32);
    return (FF / 64) * 32;
}
__device__ __forceinline__ void cvt_do(CArgs A, int kind, int layer, int item, LAS float* scr, int lane) {
    unsigned char* ws = A->ws; const int i = layer >> 1;
    if (kind == 0) {
        if (layer & 1) cvt_item(A->in[16] + (size_t)i * D * ODD_IN, D, ODD_IN, A->in[5] + layer * D, (bf16*)(ws + WS_WIN), scr, item, lane, true);
        else cvt_item(A->in[8] + (size_t)i * D * EVEN_IN, D, EVEN_IN, A->in[5] + layer * D, (bf16*)(ws + WS_WIN), scr, item, lane);
    } else if (kind == 1) {
        bf16* wt = (bf16*)(ws + WS_WOUT + (size_t)(layer & 1) * 2 * MiB);
        if (layer & 1) cvt_item(A->in[17] + (size_t)i * D * D, D, D, nullptr, wt, scr, item, lane);
        else { if (item < 256) cvt_item(A->in[9] + (size_t)i * D * D, D, D, nullptr, wt, scr, item, lane);
               else fold_item(A->in[9] + (size_t)i * D * D, A->in[14] + (size_t)i * 4 * 128 * 128, A->in[15] + i * 512, wt, scr, item - 256, lane); }
    } else if (kind == 2) cvt_item(A->in[23] + (size_t)layer * D * FF, D, FF, A->in[6] + layer * D, (bf16*)(ws + WS_WFF1), scr, item, lane);
    else cvt_item(A->in[24] + (size_t)layer * FF * D, FF, D, nullptr, (bf16*)(ws + WS_WFF2), scr, item, lane);
}
__device__ __forceinline__ void cvt_run(CArgs A, int nk, int k0, int l0, int k1, int l1, int k2, int l2, int k3, int l3, LAS unsigned char* lds, int gw, int NGW, int wave, int lane) {
    LAS float* scr = (LAS float*)(lds + wave * 16384);
    const int c0 = cvt_count(k0, l0), c1 = nk > 1 ? cvt_count(k1, l1) : 0, c2 = nk > 2 ? cvt_count(k2, l2) : 0, c3 = nk > 3 ? cvt_count(k3, l3) : 0;
    const int tot = c0 + c1 + c2 + c3;
    for (int it = gw; it < tot; it += NGW) {
        int r = it;
        if (r < c0) { cvt_do(A, k0, l0, r, scr, lane); continue; } r -= c0;
        if (r < c1) { cvt_do(A, k1, l1, r, scr, lane); continue; } r -= c1;
        if (r < c2) { cvt_do(A, k2, l2, r, scr, lane); continue; } r -= c2;
        cvt_do(A, k3, l3, r, scr, lane);
    }
}

constexpr int VS_STRIDE = 66;
constexpr int ZE = 1536;
template <int WIN> __device__ __forceinline__ void pool_rows(const bf16* Z, bf16* MIX, const float* hist, float* pout, int rbase, int tfirst, int lr0, int colx, bool sample, bool lastchunk) {
    v4u x[WIN + 7];
#pragma unroll
    for (int k = 0; k < WIN + 7; ++k) { const int t = tfirst - WIN + 1 + k;
        if (t >= 0) x[k] = *(const v4u*)(Z + (size_t)(rbase + t) * ZE + 1024 + colx);
        else if (sample) { const float* hp = hist + (size_t)(15 + t) * 512; x[k] = pack8(*(const f32x4*)hp, *(const f32x4*)(hp + 4)); }
        else x[k] = (v4u){0u, 0u, 0u, 0u}; }
    f32x4 s0 = (f32x4){0.f, 0.f, 0.f, 0.f}, s1 = s0;
#pragma unroll
    for (int k = 0; k < WIN; ++k) { f32x4 a, b; unpack8(x[k], a, b); s0 += a; s1 += b; }
#pragma unroll
    for (int i = 0; i < 8; ++i) {
        const int t = tfirst + i; f32x4 xa, xb; unpack8(x[WIN - 1 + i], xa, xb);
        const int cnti = sample ? WIN : (t + 1 < WIN ? t + 1 : WIN);
        const float inv = 1.0f / (float)cnti;
        *(v4u*)(MIX + (size_t)(rbase + t) * D + 512 + colx) = pack8(s0 * inv - xa, s1 * inv - xb);
        if (lastchunk && lr0 + i >= 49) { float* po = pout + (size_t)(lr0 + i - 49) * 512; *(f32x4*)po = xa; *(f32x4*)(po + 4) = xb; }
        if (i < 7) { f32x4 na, nb, oa, ob; unpack8(x[WIN + i], na, nb); unpack8(x[i], oa, ob); s0 += na - oa; s1 += nb - ob; }
    }
}
__device__ __forceinline__ void even_unit(CArgs A, int ie, int q, LAS unsigned char* lds, int tid, int wave, int lane) {
    const bf16* Z = (const bf16*)(A->ws + WS_Z); bf16* MIX = (bf16*)(A->ws + WS_MIX); const float* VST = (const float*)(A->ws + WS_VST);
    const int row0 = q * 64; const bool sample = row0 >= MP;
    int t0, half, seq;
    if (!sample) { t0 = row0 & (SEQ - 1); half = (t0 >> 6) & 1; seq = row0 >> 13; } else { t0 = 0; half = 0; seq = (row0 - MP) >> 6; }
    const int nj = 64 * (half + 1), jrow0 = row0 - 64 * half, ioff = 64 * half;
    LAS f32x2* stat = (LAS f32x2*)(lds + 8 * 128 * VS_STRIDE * 2);
    LAS bf16* Vs = (LAS bf16*)lds + wave * 128 * VS_STRIDE;
    __syncthreads();
    if (tid < nj) {
        const float* vp = VST + (size_t)(jrow0 + tid) * 16;
        const f32x4 p0 = *(const f32x4*)vp, p1 = *(const f32x4*)(vp + 4), p2 = *(const f32x4*)(vp + 8), p3 = *(const f32x4*)(vp + 12);
        const float s = ((p0[0] + p0[2]) + (p1[0] + p1[2])) + ((p2[0] + p2[2]) + (p3[0] + p3[2])), qq = ((p0[1] + p0[3]) + (p1[1] + p1[3])) + ((p2[1] + p2[3]) + (p3[1] + p3[3]));
        const float mean = s * (1.0f / 512.0f), var = fmaxf(qq * (1.0f / 512.0f) - mean * mean, 0.f);
        stat[tid] = (f32x2){mean, __builtin_amdgcn_rsqf(var + EPS)};
    }
    __syncthreads();
    const int h = wave;
    {
        const int c8 = (lane & 7) * 8;
        const float* gp = A->in[12] + ie * 512 + h * 64 + c8; const float* bp = A->in[13] + ie * 512 + h * 64 + c8;
        const f32x4 g0 = *(const f32x4*)gp, g1 = *(const f32x4*)(gp + 4), b0 = *(const f32x4*)bp, b1 = *(const f32x4*)(bp + 4);
        for (int bb = 0; bb < nj / 64; ++bb) {
            v4u w[8];
#pragma unroll
            for (int i = 0; i < 8; ++i) w[i] = *(const v4u*)(Z + (size_t)(jrow0 + bb * 64 + i * 8 + (lane >> 3)) * ZE + 512 + h * 64 + c8);
#pragma unroll
            for (int i = 0; i < 8; ++i) {
                const int r = bb * 64 + i * 8 + (lane >> 3); f32x4 a, b; unpack8(w[i], a, b);
                const f32x2 st = stat[r];
                a = (a - st.x) * st.y * g0 + b0; b = (b - st.x) * st.y * g1 + b1;
                const v4u o = pack8(a, b);
                LAS unsigned* dst = (LAS unsigned*)(Vs + r * VS_STRIDE + c8);
                dst[0] = o.x; dst[1] = o.y; dst[2] = o.z; dst[3] = o.w;
                if (sample) { float* vo = A->out + O_AV_S + ((size_t)(ie * 32 + seq) * 64 + r) * 512 + h * 64 + c8; *(f32x4*)vo = a; *(f32x4*)(vo + 4) = b; }
            }
        }
    }
    asm volatile("s_waitcnt lgkmcnt(0)" ::: "memory");
    {
        const int fr = lane & 15, fq = lane >> 4;
        f32x4 acc[4][4];
#pragma unroll
        for (int a = 0; a < 4; ++a)
#pragma unroll
            for (int b = 0; b < 4; ++b) acc[a][b] = (f32x4){0.f, 0.f, 0.f, 0.f};
        const float* Wh = A->in[10] + ((size_t)(ie * 8 + h) * 128 + ioff) * 128 + (size_t)fr * 128 + 8 * fq;
        v2u uw[4][4]; float bias[4];
#pragma unroll
        for (int it = 0; it < 4; ++it) { bias[it] = A->in[11][(ie * 8 + h) * 128 + ioff + it * 16 + fr];
#pragma unroll
            for (int ct = 0; ct < 4; ++ct) uw[it][ct] = *(const v2u*)(Z + (size_t)(row0 + it * 16 + fr) * ZE + h * 64 + ct * 16 + 4 * fq); }
        f32x4 wn[4][2];
#pragma unroll
        for (int it = 0; it < 4; ++it) { wn[it][0] = *(const f32x4*)(Wh + it * 16 * 128); wn[it][1] = *(const f32x4*)(Wh + it * 16 * 128 + 4); }
        const int nks = nj / 32;
        for (int ks = 0; ks < nks; ++ks) {
            bf16x8 av[4], bv[4];
#pragma unroll
            for (int it = 0; it < 4; ++it) { const v4u pk = pack8(wn[it][0], wn[it][1]); bv[it] = __builtin_bit_cast(bf16x8, pk); }
            if (ks + 1 < nks) {
#pragma unroll
                for (int it = 0; it < 4; ++it) { wn[it][0] = *(const f32x4*)(Wh + it * 16 * 128 + (ks + 1) * 32); wn[it][1] = *(const f32x4*)(Wh + it * 16 * 128 + (ks + 1) * 32 + 4); } }
#pragma unroll
            for (int ct = 0; ct < 4; ++ct) {
                const LAS bf16* p = Vs + (ks * 32 + 8 * fq) * VS_STRIDE + ct * 16 + fr;
#pragma unroll
                for (int e = 0; e < 8; ++e) av[ct][e] = (short)p[e * VS_STRIDE];
            }
#pragma unroll
            for (int ct = 0; ct < 4; ++ct)
#pragma unroll
                for (int it = 0; it < 4; ++it) acc[ct][it] = __builtin_amdgcn_mfma_f32_16x16x32_bf16(av[ct], bv[it], acc[ct][it], 0, 0, 0);
        }
#pragma unroll
        for (int it = 0; it < 4; ++it) {
            const int row = row0 + it * 16 + fr;
#pragma unroll
            for (int ct = 0; ct < 4; ++ct) {
                const int col = h * 64 + ct * 16 + 4 * fq;
                const f32x4 uu = (f32x4){bflo(uw[it][ct].x), bfhi(uw[it][ct].x), bflo(uw[it][ct].y), bfhi(uw[it][ct].y)};
                const f32x4 y = uu * (acc[ct][it] + bias[it]);
                v2u o; o.x = pk2(y[0], y[1]); o.y = pk2(y[2], y[3]);
                *(v2u*)(MIX + (size_t)row * D + col) = o;
            }
        }
    }
    {
        const int g = wave & 3, rh = wave >> 2, cb = lane & 15, rs = lane >> 4;
        const int colx = g * 128 + cb * 8;
        const int rbase = row0 - t0;
        const bool lastchunk = sample || (t0 == SEQ - 64);
        const float* hist = A->in[2] + ((size_t)(ie * 32 + seq) * 15) * 512 + colx;
        float* pout = sample ? (A->out + O_POOL_S + ((size_t)(ie * 32 + seq) * 15) * 512 + colx) : (A->out + O_POOL_P + ((size_t)(ie * 2 + seq) * 15) * 512 + colx);
        const int lr0 = 32 * rh + 8 * rs, tfirst = t0 + lr0;
        if (g == 0) pool_rows<2>(Z, MIX, hist, pout, rbase, tfirst, lr0, colx, sample, lastchunk);
        else if (g == 1) pool_rows<4>(Z, MIX, hist, pout, rbase, tfirst, lr0, colx, sample, lastchunk);
        else if (g == 2) pool_rows<8>(Z, MIX, hist, pout, rbase, tfirst, lr0, colx, sample, lastchunk);
        else pool_rows<16>(Z, MIX, hist, pout, rbase, tfirst, lr0, colx, sample, lastchunk);
    }
}

__device__ __forceinline__ void odd_unit(CArgs A, int io, int q, LAS unsigned char* lds, int tid, int wave, int lane) {
    const bf16* Z = (const bf16*)(A->ws + WS_Z); bf16* MIX = (bf16*)(A->ws + WS_MIX);
    const int row0 = q * 64; const bool sample = row0 >= MP;
    int t0, seq;
    if (!sample) { t0 = row0 & (SEQ - 1); seq = row0 >> 13; } else { t0 = 0; seq = (row0 - MP) >> 6; }
    const int rbase = row0 - t0; const int T = sample ? 64 : SEQ; const bool lastchunk = sample || (t0 == SEQ - 64);
    LAS bf16* cin = (LAS bf16*)lds;
    LAS float* cbuf = (LAS float*)(lds + 94 * 1024);
    {
        const int cb = tid & 63, rg = tid >> 6, ch = cb * 8;
        const float* dw = A->in[22] + (size_t)io * 3 * 512 + ch;
        const f32x4 w0a = *(const f32x4*)dw, w0b = *(const f32x4*)(dw + 4), w1a = *(const f32x4*)(dw + 512), w1b = *(const f32x4*)(dw + 516), w2a = *(const f32x4*)(dw + 1024), w2b = *(const f32x4*)(dw + 1028);
        const float* hd = A->in[4] + ((size_t)(io * 32 + seq) * 2) * 512 + ch;
        float* dout = sample ? (A->out + O_CD_S + ((size_t)(io * 32 + seq) * 2) * 512 + ch) : (A->out + O_CD_P + ((size_t)(io * 2 + seq) * 2) * 512 + ch);
        const int tf = t0 + 8 * rg;
        v4u dgw[10], gbw[8];
#pragma unroll
        for (int k = 0; k < 10; ++k) { const int t = tf - 2 + k;
            if (t >= 0) dgw[k] = *(const v4u*)(Z + (size_t)(rbase + t) * ZE + 1024 + ch);
            else if (sample) { const float* hp = hd + (size_t)(2 + t) * 512; dgw[k] = pack8(*(const f32x4*)hp, *(const f32x4*)(hp + 4)); }
            else dgw[k] = (v4u){0u, 0u, 0u, 0u}; }
#pragma unroll
        for (int i = 0; i < 8; ++i) gbw[i] = *(const v4u*)(Z + (size_t)(rbase + tf + i) * ZE + 512 + ch);
        f32x4 m2a, m2b, m1a, m1b; unpack8(dgw[0], m2a, m2b); unpack8(dgw[1], m1a, m1b);
#pragma unroll
        for (int i = 0; i < 8; ++i) {
            const int t = tf + i; f32x4 da, db, ga, gb; unpack8(dgw[2 + i], da, db); unpack8(gbw[i], ga, gb);
            const f32x4 ya = ga * (w0a * m2a + w1a * m1a + w2a * da), yb = gb * (w0b * m2b + w1b * m1b + w2b * db);
            *(v4u*)(MIX + (size_t)(rbase + t) * D + 512 + ch) = pack8(ya, yb);
            const int lr = 8 * rg + i;
            if (lastchunk && lr >= 62) { float* po = dout + (size_t)(lr - 62) * 512; *(f32x4*)po = da; *(f32x4*)(po + 4) = db; }
            m2a = m1a; m2b = m1b; m1a = da; m1b = db;
        }
    }
    __syncthreads();
    {
        const float* hc = A->in[3] + ((size_t)(io * 32 + seq) * 30) * 512;
        float* cout = sample ? (A->out + O_CC_S + ((size_t)(io * 32 + seq) * 30) * 512) : (A->out + O_CC_P + ((size_t)(io * 2 + seq) * 30) * 512);
        for (int base = tid; base < 94 * 64; base += 4 * NTHR) {
            v4u w[4];
#pragma unroll
            for (int u = 0; u < 4; ++u) { const int item = base + u * NTHR, lr = item >> 6, cb = item & 63, t = t0 + lr - 30;
                if (item < 94 * 64 && t >= 0) w[u] = *(const v4u*)(Z + (size_t)(rbase + t) * ZE + cb * 8);
                else if (item < 94 * 64 && sample) { const float* hp = hc + (size_t)(30 + t) * 512 + cb * 8; w[u] = pack8(*(const f32x4*)hp, *(const f32x4*)(hp + 4)); }
                else w[u] = (v4u){0u, 0u, 0u, 0u}; }
#pragma unroll
            for (int u = 0; u < 4; ++u) { const int item = base + u * NTHR, lr = item >> 6, cb = item & 63, t = t0 + lr - 30;
                if (item < 94 * 64) {
                    *(LAS v4u*)(cin + lr * 512 + cb * 8) = w[u];
                    if (lastchunk && lr >= 30 && t >= T - 30) { f32x4 a, b; unpack8(w[u], a, b); float* po = cout + (size_t)(t - (T - 30)) * 512 + cb * 8; *(f32x4*)po = a; *(f32x4*)(po + 4) = b; } } }
        }
    }
    __syncthreads();
    {
        const int cp = tid & 255, rq = tid >> 8;
        f32x2 w[31];
#pragma unroll
        for (int k = 0; k < 31; ++k) w[k] = *(const f32x2*)(A->in[18] + ((size_t)io * 31 + k) * 512 + 2 * cp);
        const f32x2 cbias = *(const f32x2*)(A->in[19] + io * 512 + 2 * cp);
        const float* lg = A->in[20] + io * 512 + lane * 8; const float* lb = A->in[21] + io * 512 + lane * 8;
        const f32x4 g0 = *(const f32x4*)lg, g1 = *(const f32x4*)(lg + 4), b0 = *(const f32x4*)lb, b1 = *(const f32x4*)(lb + 4);
        for (int sb = 0; sb < 4; ++sb) {
            const int r0 = 16 * sb + 8 * rq;
            f32x2 acc[8];
#pragma unroll
            for (int i = 0; i < 8; ++i) acc[i] = cbias;
#pragma unroll
            for (int j = 0; j < 38; ++j) { const unsigned xw = *(const LAS unsigned*)(cin + (r0 + j) * 512 + 2 * cp); const f32x2 x = (f32x2){bflo(xw), bfhi(xw)};
#pragma unroll
                for (int i = 0; i < 8; ++i) { if (j - i >= 0 && j - i < 31) acc[i] += w[j - i] * x; } }
#pragma unroll
            for (int i = 0; i < 8; ++i) *(LAS f32x2*)(cbuf + (8 * rq + i) * 512 + 2 * cp) = acc[i];
            __syncthreads();
#pragma unroll
            for (int rr = 0; rr < 2; ++rr) {
                const int lr = 2 * wave + rr;
                f32x4 a = *(const LAS f32x4*)(cbuf + lr * 512 + lane * 8), b = *(const LAS f32x4*)(cbuf + lr * 512 + lane * 8 + 4);
                const float s = wave_sum((a[0] + a[1]) + (a[2] + a[3]) + (b[0] + b[1]) + (b[2] + b[3]));
                const float mean = s * (1.0f / 512.0f);
                a = a - mean; b = b - mean;
                const float qq = wave_sum((a[0] * a[0] + a[1] * a[1]) + (a[2] * a[2] + a[3] * a[3]) + (b[0] * b[0] + b[1] * b[1]) + (b[2] * b[2] + b[3] * b[3]));
                const float rstd = __builtin_amdgcn_rsqf(qq * (1.0f / 512.0f) + EPS);
                a = a * rstd * g0 + b0; b = b * rstd * g1 + b1;
#pragma unroll
                for (int e = 0; e < 4; ++e) { a[e] = a[e] * sigmoidf_(a[e]); b[e] = b[e] * sigmoidf_(b[e]); }
                *(v4u*)(MIX + (size_t)(row0 + 16 * sb + lr) * D + lane * 8) = pack8(a, b);
            }
            __syncthreads();
        }
    }
}

#define RLX_AGENT __ATOMIC_RELAXED, __HIP_MEMORY_SCOPE_AGENT
#define XB_TMO      128
#define XB_XCNT(j)  (256  + 64 * (j))
#define XB_XSUB(j)  (1280 + 64 * (j))
#define XB_XGEN(j)  (2304 + 64 * (j))
#define XB_TOP      3328
#define XB_TOPGEN   3392
#define XCD_BAR_WORDS 3456
#define XB_SPIN_CAP (1u << 18)

__device__ __forceinline__ unsigned xb_ld(unsigned* p)              { return __hip_atomic_load(p, __ATOMIC_RELAXED, __HIP_MEMORY_SCOPE_AGENT); }
__device__ __forceinline__ unsigned xb_add(unsigned* p, unsigned v) { return __hip_atomic_fetch_add(p, v, __ATOMIC_RELAXED, __HIP_MEMORY_SCOPE_AGENT); }
__device__ __forceinline__ unsigned xb_xcc_id() { return (unsigned)__builtin_amdgcn_s_getreg((3 << 11) | 20) & 0xFu; }
#define XB_SPIN(cond, bar) do { unsigned _sp = 0; while (cond) { __builtin_amdgcn_s_sleep(1); \
    if ((++_sp & 255u) == 0u) { if (xb_ld(&(bar)[XB_TMO])) break; if (_sp > XB_SPIN_CAP) { atomicAdd(&(bar)[XB_TMO], 1u); break; } } } } while (0)

struct XcdBarrier {
    unsigned* bar; unsigned x;
    volatile LAS unsigned* st;
};

__device__ __forceinline__ XcdBarrier xcd_barrier_post(unsigned* bar, volatile LAS unsigned* st) {
    XcdBarrier b; b.bar = bar; b.x = xb_xcc_id(); b.st = st;
    if (threadIdx.x == 0) (void)xb_add(&bar[XB_XCNT(b.x)], 1u);
    return b;
}
__device__ __forceinline__ void xcd_barrier_complete(unsigned* bar, unsigned x, unsigned& nloc, unsigned& nx) {
    const unsigned G = gridDim.x * gridDim.y * gridDim.z;
    unsigned sum, cnt, mine, sp = 0u;
    for (;;) {
        sum = 0u; cnt = 0u; mine = 0u;
#pragma unroll
        for (unsigned j = 0; j < 16; ++j) { const unsigned c = xb_ld(&bar[XB_XCNT(j)]); sum += c; cnt += (c > 0u) ? 1u : 0u; mine = (j == x) ? c : mine; }
        if (sum == G) break;
        __builtin_amdgcn_s_sleep(1);
        if ((++sp & 255u) == 0u) { if (xb_ld(&bar[XB_TMO])) break; if (sp > XB_SPIN_CAP) { atomicAdd(&bar[XB_TMO], 1u); break; } }
    }
    nloc = mine > 0u ? mine : 1u; nx = cnt > 0u ? cnt : 1u;
}

__device__ __forceinline__ void xcd_barrier(const XcdBarrier& b) {
    asm volatile("s_waitcnt vmcnt(0)" ::: "memory");
    __syncthreads();
    if (threadIdx.x == 0) {
        unsigned* bar = b.bar;
        __builtin_amdgcn_s_waitcnt(0);
        unsigned nloc = b.st[0], nx = b.st[1];
        if (nloc == 0u) { xcd_barrier_complete(bar, b.x, nloc, nx); b.st[0] = nloc; b.st[1] = nx; }
        const unsigned old = xb_add(&bar[XB_XSUB(b.x)], 1u);
        const unsigned gen = old / nloc;
        if (old + 1u == (gen + 1u) * nloc) {
            __builtin_amdgcn_fence(__ATOMIC_RELEASE, "agent");
            asm volatile("s_waitcnt vmcnt(0)" ::: "memory");
            const unsigned og = xb_add(&bar[XB_TOP], 1u);
            const unsigned tg = og / nx;
            if (og + 1u == (tg + 1u) * nx) xb_add(&bar[XB_TOPGEN], 1u);
            else XB_SPIN(xb_ld(&bar[XB_TOPGEN]) == tg, bar);
            __builtin_amdgcn_fence(__ATOMIC_ACQUIRE, "agent");
            xb_add(&bar[XB_XGEN(b.x)], 1u);
            asm volatile("s_waitcnt vmcnt(0)" ::: "memory");
        } else {
            XB_SPIN(xb_ld(&bar[XB_XGEN(b.x)]) == gen, bar);
            __builtin_amdgcn_fence(__ATOMIC_ACQUIRE, "agent");
            asm volatile("s_waitcnt vmcnt(0)" ::: "memory");
        }
    }
    __syncthreads();
}

__global__ void __launch_bounds__(NTHR, 2) fwd_megakernel(Args A_unused) {
    extern __shared__ __attribute__((aligned(16))) unsigned char lds_raw[];
    LAS unsigned char* lds = (LAS unsigned char*)lds_raw;
    cg::grid_group grid = cg::this_grid();
    const CArgs A0 = (CArgs)__builtin_amdgcn_kernarg_segment_ptr();
    const int G = gridDim.x, bx = blockIdx.x;
    volatile LAS unsigned* xst = (volatile LAS unsigned*)(lds + LDS_BYTES - 64);
    if (threadIdx.x < 2) xst[threadIdx.x] = 0u;
    __syncthreads();
    const XcdBarrier xbar = xcd_barrier_post((unsigned*)(A0->ws + WS_BAR), xst);
#define GRID_SYNC1() xcd_barrier(xbar)
#define GRID_SYNC_CG() do { asm volatile("s_waitcnt vmcnt(0) lgkmcnt(0)" ::: "memory"); grid.sync(); } while (0)
#if PROBE_SYNC2
#define GRID_SYNC() do { GRID_SYNC1(); GRID_SYNC1(); } while (0)
#else
#define GRID_SYNC() GRID_SYNC1()
#endif
#define GRID_SYNC_UNUSED() do { } while (0)
#define PHASE_BEGIN() CArgs A = A0; LAUNDER_S(A); int tid = threadIdx.x; LAUNDER_V(tid); const int lane = tid & 63, wave = __builtin_amdgcn_readfirstlane(tid >> 6); const int gw = bx * NWAVES + wave, NGW = G * NWAVES; \
    unsigned char* ws = A->ws; float* X = A->out + O_Y; float* SS = (float*)(ws + WS_SS); bf16* XB = (bf16*)(ws + WS_XB); (void)lane; (void)gw; (void)NGW; (void)X; (void)SS; (void)XB

    {
        PHASE_BEGIN();
        cvt_run(A, 2, 0, 0, 1, 0, 0, 0, 0, 0, lds, gw, NGW, wave, lane);
        for (int m0 = gw; m0 < M; m0 += 3 * NGW) {
            f32x4 v[3][4];
#pragma unroll
            for (int r = 0; r < 3; ++r) { const int m = m0 + r * NGW; if (m < M) { const float* src = (m < MP) ? (A->in[0] + (size_t)m * D) : (A->in[1] + (size_t)(m - MP) * D);
#pragma unroll
                for (int j = 0; j < 4; ++j) v[r][j] = *(const f32x4*)(src + (lane + 64 * j) * 4); } }
#pragma unroll
            for (int r = 0; r < 3; ++r) { const int m = m0 + r * NGW; if (m < M) { float s2 = 0.f;
#pragma unroll
                for (int j = 0; j < 4; ++j) { s2 += (v[r][j][0] * v[r][j][0] + v[r][j][1] * v[r][j][1]) + (v[r][j][2] * v[r][j][2] + v[r][j][3] * v[r][j][3]);
                    v2u o; o.x = pk2(v[r][j][0], v[r][j][1]); o.y = pk2(v[r][j][2], v[r][j][3]); *(v2u*)(XB + (size_t)m * D + (lane + 64 * j) * 4) = o; }
                s2 = wave_sum(s2);
                if (lane < 4) *(f32x4*)(SS + (size_t)m * 16 + lane * 4) = (f32x4){lane == 0 ? s2 : 0.f, 0.f, 0.f, 0.f}; } }
        }
    }
    GRID_SYNC_CG();

#pragma unroll 1
    for (int layer = 0; layer < 4; ++layer) {
        const int i2 = layer >> 1; const bool odd = layer & 1;
#pragma unroll 1
        for (int rep = 0; rep < 1 + PROBE_IN2; ++rep) {
        if (!odd) { PHASE_BEGIN(); pg8::Gemm g{XB, (const bf16*)(ws + WS_WIN), M, EVEN_IN, D}; pg8::StaticOrderT<6> S; S.init(D, G, bx);
            pg8::EpiAct<0> E{(bf16*)(ws + WS_Z), EVEN_IN, SS + (size_t)(2 * layer) * M * 16, (float*)(ws + WS_VST)};
            pg8::gemm_phase<pg8::EpiAct<0>, pg8::StaticOrderT<6>, true, true>(lds, g, S, E, tid); }
        else { PHASE_BEGIN(); pg8::Gemm g{XB, (const bf16*)(ws + WS_WIN), M, ODD_IN, D}; pg8::StaticOrderT<10> S; S.init(D, G, bx);
            pg8::EpiOdd E{(bf16*)(ws + WS_Z), SS + (size_t)(2 * layer) * M * 16};
            pg8::gemm_phase<pg8::EpiOdd, pg8::StaticOrderT<10>, true, true>(lds, g, S, E, tid); } }
        GRID_SYNC();
#pragma unroll 1
        for (int rep = 0; rep < 1 + PROBE_MIX2; ++rep) {
        if (!odd) { PHASE_BEGIN(); for (int q = bx; q < M / 64; q += G) even_unit(A, i2, q, lds, tid, wave, lane); }
        else { PHASE_BEGIN(); for (int q = bx; q < M / 64; q += G) odd_unit(A, i2, q, lds, tid, wave, lane); }
        __syncthreads(); }
#pragma unroll 1
        for (int rep = 0; rep < 1 + PROBE_CVT2; ++rep)
        { PHASE_BEGIN();
          const bool skew = (G == 256); const int cgw = skew ? gw - 32 * NWAVES : gw, cng = skew ? NGW - 32 * NWAVES : NGW;
          if (cgw >= 0 && layer == 0) cvt_run(A, 1, 2, 0, 0, 0, 0, 0, 0, 0, lds, cgw, cng, wave, lane); }
        GRID_SYNC();
#pragma unroll 1
        for (int rep = 0; rep < 1 + PROBE_OUT2; ++rep)
        { PHASE_BEGIN(); pg8::Gemm g{(const bf16*)(ws + WS_MIX), (const bf16*)(ws + WS_WOUT + (size_t)(layer & 1) * 2 * MiB), M, D, D}; pg8::EpiRes E{X, ws, 2 * layer};
#if PROBE_OUT2 || PROBE_FF2X2
          E.dry = rep < PROBE_OUT2;
#endif

          if (G == 256) { pg8::TailOrder256 S; S.init(D, G, bx); pg8::gemm_phase<pg8::EpiRes, pg8::TailOrder256, true, true>(lds, g, S, E, tid); }
          else { pg8::StaticOrderT<4> S; S.init(D, G, bx); pg8::gemm_phase<pg8::EpiRes, pg8::StaticOrderT<4>, true, true>(lds, g, S, E, tid); } }
        { PHASE_BEGIN();
          const bool skew = (G == 256); const int cgw = skew ? gw - 128 * NWAVES : gw, cng = skew ? NGW - 128 * NWAVES : NGW;
          if (cgw >= 0) { if (layer < 3) cvt_run(A, 2, 3, layer, 0, layer + 1, 0, 0, 0, 0, lds, cgw, cng, wave, lane); else cvt_run(A, 1, 3, layer, 0, 0, 0, 0, 0, 0, lds, cgw, cng, wave, lane); } }
        GRID_SYNC();
#pragma unroll 1
        for (int rep = 0; rep < 1 + PROBE_FF1X2; ++rep)
        { PHASE_BEGIN(); pg8::Gemm g{XB, (const bf16*)(ws + WS_WFF1), M, FF, D}; pg8::StaticOrderT<16> S; S.init(D, G, bx);
          pg8::EpiAct<2> E{(bf16*)(ws + WS_H), FF, SS + (size_t)(2 * layer + 1) * M * 16, nullptr};
          pg8::gemm_phase<pg8::EpiAct<2>, pg8::StaticOrderT<16>, true, true>(lds, g, S, E, tid); }
        GRID_SYNC();
#pragma unroll 1
        for (int rep = 0; rep < 1 + PROBE_FF2X2; ++rep)
        { PHASE_BEGIN(); pg8::Gemm g{(const bf16*)(ws + WS_H), (const bf16*)(ws + WS_WFF2), M, D, FF}; pg8::EpiRes E{X, ws, 2 * layer + 1};
#if PROBE_OUT2 || PROBE_FF2X2
          E.dry = rep < PROBE_FF2X2;
#endif

          if (G == 256) { pg8::TailOrder256 S; S.init(FF, G, bx); pg8::gemm_phase<pg8::EpiRes, pg8::TailOrder256, true, true>(lds, g, S, E, tid); }
          else { pg8::StaticOrderT<4> S; S.init(FF, G, bx); pg8::gemm_phase<pg8::EpiRes, pg8::StaticOrderT<4>, true, true>(lds, g, S, E, tid); } }
        if (layer < 3) { PHASE_BEGIN();
          const bool skew = (G == 256); const int cgw = skew ? gw - 128 * NWAVES : gw, cng = skew ? NGW - 128 * NWAVES : NGW;
          if (cgw >= 0) cvt_run(A, 2, 1, layer + 1, 2, layer + 1, 0, 0, 0, 0, lds, cgw, cng, wave, lane); }
        GRID_SYNC();
    }
    {
        PHASE_BEGIN();
        const float* fg = A->in[7]; const float* ss = SS + (size_t)8 * M * 16;
        f32x4 gv[4];
#pragma unroll
        for (int j = 0; j < 4; ++j) gv[j] = *(const f32x4*)(fg + (lane + 64 * j) * 4);
        for (int m0 = gw; m0 < M; m0 += 3 * NGW) {
            f32x4 v[3][4]; float sp[3];
#pragma unroll
            for (int r = 0; r < 3; ++r) { const int m = m0 + r * NGW; if (m < M) { sp[r] = lane < 16 ? ss[(size_t)m * 16 + lane] : 0.f;
#pragma unroll
                for (int j = 0; j < 4; ++j) v[r][j] = *(const f32x4*)(X + (size_t)m * D + (lane + 64 * j) * 4); } }
#pragma unroll
            for (int r = 0; r < 3; ++r) { const int m = m0 + r * NGW; if (m < M) { const float rs = __builtin_amdgcn_rsqf(wave_sum(sp[r]) * (1.0f / 1024.0f) + EPS);
#pragma unroll
                for (int j = 0; j < 4; ++j) *(f32x4*)(X + (size_t)m * D + (lane + 64 * j) * 4) = v[r][j] * rs * gv[j]; } }
        }
    }
}

extern "C" void kernel_launch(void* const* d_in, const int* in_sizes, int n_in, void* d_out, int out_size, void* d_ws, size_t ws_size, hipStream_t stream) {
    static int grid = 0;
    if (grid == 0) {
        if (n_in != 25 || (size_t)out_size != O_END || ws_size < WS_END) { fprintf(stderr, "kernel_launch: unexpected shapes (n_in %d out %d ws %zu)\n", n_in, out_size, ws_size); grid = -1; return; }
        int dev = 0, cus = 0, per_cu = 0;
        (void)hipGetDevice(&dev); (void)hipDeviceGetAttribute(&cus, hipDeviceAttributeMultiprocessorCount, dev);
        (void)hipFuncSetAttribute((const void*)fwd_megakernel, hipFuncAttributeMaxDynamicSharedMemorySize, LDS_BYTES);
        (void)hipOccupancyMaxActiveBlocksPerMultiprocessor(&per_cu, (const void*)fwd_megakernel, NTHR, LDS_BYTES);
        (void)hipGetLastError();
        if (per_cu < 1) per_cu = 1;
        grid = cus * per_cu;
        fprintf(stderr, "kernel_launch: cus %d per_cu %d grid %d ws %zu\n", cus, per_cu, grid, ws_size);
    }
    if (grid < 0) return;
    (void)hipMemsetAsync((unsigned char*)d_ws + WS_CNT, 0, ZERO_BYTES, stream);
    Args a{};
    for (int i = 0; i < 25; ++i) a.in[i] = (const float*)d_in[i];
    a.out = (float*)d_out; a.ws = (unsigned char*)d_ws;
    void* args[] = {&a};
    hipError_t e = hipLaunchCooperativeKernel((const void*)fwd_megakernel, dim3(grid), dim3(NTHR), args, LDS_BYTES, stream);
    if (e != hipSuccess) fprintf(stderr, "cooperative launch failed: %s (grid %d)\n", hipGetErrorString(e), grid);
}
```

```cpp
#include <hip/hip_runtime.h>
#include <hip/hip_cooperative_groups.h>
#include <cstdio>
#include <cstdint>
#ifndef PROBE_SYNC2
#define PROBE_SYNC2 0
#define PROBE_MIX2 0
#define PROBE_CVT2 0
#define PROBE_FF1X2 0
#define PROBE_IN2 0
#define PROBE_OUT2 0
#define PROBE_FF2X2 0
#endif
namespace pg8 {
#define PG8_LAS __attribute__((address_space(3)))
typedef unsigned short bf16_t;
typedef short bf16x8 __attribute__((ext_vector_type(8)));
typedef float f32x4 __attribute__((ext_vector_type(4)));
typedef unsigned u32x4 __attribute__((ext_vector_type(4)));
constexpr int BM = 256, BK = 64, HALF = 128, HTB = HALF * BK * 2  , STAGE_BYTES = 8 * HTB, NXCD = 8, WGM = 8;

__host__ __device__ __forceinline__ int lds_byte(int r, int c) { const int st = (r >> 4) * 2 + (c >> 5), rr = r & 15, cc = c & 31, ob = rr * 64 + cc * 2; return st * 1024 + (ob ^ (((ob >> 9) & 1) << 5)); }
__host__ __device__ __forceinline__ void stage_rc(int b, int& R, int& C) { const int st = b / 1024, sb = b % 1024, swz = sb ^ (((sb >> 9) & 1) << 5); R = (st >> 1) * 16 + swz / 64; C = (st & 1) * 32 + (swz % 64) / 2; }
__host__ __device__ __forceinline__ int perm32(int rho) { const int n = rho >> 4, i = rho & 15; return 8 * (i >> 2) + 4 * n + (i & 3); }

struct Unit { int pm, pn, kt0, nkt, split; };
struct Gemm { const bf16_t* A; const bf16_t* Bt; int M, N, K; };

template <int NN> struct StaticOrderT {
    static constexpr int nM = 72, nN = NN, nwg = nM * nN, nkt_unused = 0;
    int G, c, nkt;
    __host__ __device__ void init(int K, int G_, int c_) { G = G_; c = c_; nkt = K / BK; }
    __host__ __device__ static void tile_of(int L, Unit& u) {
        static_assert(nwg % NXCD == 0 && nM % WGM == 0, "order constants");
        const int q = nwg / NXCD, xcd = L % NXCD, off = L / NXCD, wgid = xcd * q + off;
        const int nig = WGM * nN, gid = wgid / nig, fm = gid * WGM;
        u.pm = fm + ((wgid % nig) % WGM); u.pn = (wgid % nig) / WGM; }
    __host__ __device__ bool next(int i, Unit& u) const {
        const int L = i * G + c; if (L >= nwg) return false;
        tile_of(L, u); u.kt0 = 0; u.nkt = nkt; u.split = -1; return true;
    }
    __device__ __forceinline__ void a_ready(const Unit&) const {}
    __device__ __forceinline__ void done(const Unit&) const {}
};
constexpr int NS = 4;
struct TailOrder256 : StaticOrderT<4> {
    __host__ __device__ bool next(int i, Unit& u) const {
        const bool has_tail = c < 32 * NS, tail_now = has_tail && i == 0, full_now = has_tail ? (i == 1) : (i == 0);
        if (!(tail_now || full_now)) return false;
        tile_of(tail_now ? 256 + c / NS : c, u);
        u.nkt = tail_now ? nkt / NS : nkt; u.split = tail_now ? c % NS : -1; u.kt0 = tail_now ? (c % NS) * (nkt / NS) : 0;
        return true;
    }
};
__device__ __forceinline__ unsigned cvt_pk_bf16(float lo, float hi) { unsigned r; asm volatile("v_cvt_pk_bf16_f32 %0, %1, %2" : "=v"(r) : "v"(lo), "v"(hi)); return r; }
typedef float f32x2 __attribute__((ext_vector_type(2)));
constexpr float NORM_EPS = 1e-6f;
constexpr size_t EPI_WS_XB = (size_t)26 << 20, EPI_WS_SS = (size_t)206 << 20, EPI_WS_PART = (size_t)218 << 20, EPI_WS_CNT = (size_t)250 << 20;
typedef float f32x2e __attribute__((ext_vector_type(2)));
__device__ __forceinline__ float gelu_tanh(float v) {
    const float z = v * (1.0f + 0.044715f * v * v) * (-1.5957691216f * 1.4426950409f);
    return v * __builtin_amdgcn_rcpf(1.0f + __builtin_amdgcn_exp2f(z));
}
__device__ __forceinline__ float sigm(float g) { return __builtin_amdgcn_rcpf(1.0f + __builtin_amdgcn_exp2f(g * -1.4426950409f)); }
__device__ __forceinline__ float row_rstd(const float* ss, int row, int fq) {
    const f32x4 sp = *(const f32x4*)(ss + (size_t)row * 16 + fq * 4); float sr = (sp[0] + sp[1]) + (sp[2] + sp[3]); sr += __shfl_xor(sr, 16); sr += __shfl_xor(sr, 32);
    return __builtin_amdgcn_rsqf(sr * (1.0f / 1024.0f) + NORM_EPS);
}
__device__ __forceinline__ void row_rstd8(const float* ss, int row0, int fq, float (&rs)[2][4]) {
    f32x4 sp[2][4];
#pragma unroll
    for (int ai = 0; ai < 2; ++ai)
#pragma unroll
        for (int m = 0; m < 4; ++m) sp[ai][m] = *(const f32x4*)(ss + (size_t)(row0 + ai * HALF + m * 16) * 16 + fq * 4);
    asm volatile("" ::: "memory");
#pragma unroll
    for (int ai = 0; ai < 2; ++ai)
#pragma unroll
        for (int m = 0; m < 4; ++m) { float sr = (sp[ai][m][0] + sp[ai][m][1]) + (sp[ai][m][2] + sp[ai][m][3]); sr += __shfl_xor(sr, 16); sr += __shfl_xor(sr, 32);
            rs[ai][m] = __builtin_amdgcn_rsqf(sr * (1.0f / 1024.0f) + NORM_EPS); }
}
template <int MODE> struct EpiAct {
    static constexpr bool PERM = true, AFTER_DRAIN = false;
    bf16_t* O; int ldc; const float* ss; float* vst;
    __device__ __forceinline__ void operator()(f32x4 (&acc)[2][2][4][2], const Unit& u, int wr, int wc, int fr_, int fq_, int wid, int lane_) const {
        int fr = fr_, fq = fq_, lane = lane_; asm volatile("" : "+v"(fr), "+v"(fq), "+v"(lane));
        const int row0 = u.pm * BM + wr * 64 + fr, col0 = u.pn * BM + wc * 32 + 8 * fq;
        const bool act = (MODE == 0) && (u.pn < 4); const bool st = (MODE == 0) && (u.pn == 2 || u.pn == 3);
        float rsv[2][4]; row_rstd8(ss, row0, fq, rsv);
#pragma unroll
        for (int ai = 0; ai < 2; ++ai)
#pragma unroll
            for (int m = 0; m < 4; ++m) { const int row = row0 + ai * HALF + m * 16; const float rs = rsv[ai][m];
                bf16_t* rowp = O + (size_t)row * ldc + col0; float s1 = 0.f, s2 = 0.f;
#pragma unroll
                for (int bj = 0; bj < 2; ++bj) { f32x4 v0 = acc[ai][bj][m][0] * rs, v1 = acc[ai][bj][m][1] * rs;
                    if (MODE == 0) { if (act) {
#pragma unroll
                        for (int e = 0; e < 4; ++e) { v0[e] = gelu_tanh(v0[e]); v1[e] = gelu_tanh(v1[e]); } }
                        if (st) { s1 += (v0[0] + v0[1]) + (v0[2] + v0[3]) + (v1[0] + v1[1]) + (v1[2] + v1[3]);
                                  s2 += (v0[0] * v0[0] + v0[1] * v0[1]) + (v0[2] * v0[2] + v0[3] * v0[3]) + (v1[0] * v1[0] + v1[1] * v1[1]) + (v1[2] * v1[2] + v1[3] * v1[3]); } }
                    if (MODE == 2) {
#pragma unroll
                        for (int e = 0; e < 4; ++e) { const float a = fmaxf(v0[e], 0.f), b = fmaxf(v1[e], 0.f); v0[e] = a * a; v1[e] = b * b; } }
                    u32x4 w; w.x = cvt_pk_bf16(v0[0], v0[1]); w.y = cvt_pk_bf16(v0[2], v0[3]); w.z = cvt_pk_bf16(v1[0], v1[1]); w.w = cvt_pk_bf16(v1[2], v1[3]);
                    *(u32x4*)(rowp + bj * HALF) = w; }
                if (MODE == 0) { if (st) { s1 += __shfl_xor(s1, 16); s1 += __shfl_xor(s1, 32); s2 += __shfl_xor(s2, 16); s2 += __shfl_xor(s2, 32);
                    if (fq == 0) *(f32x2e*)(vst + (size_t)row * 16 + ((u.pn - 2) * 4 + wc) * 2) = (f32x2e){s1, s2}; } } }
    }
};
struct EpiOdd {
    static constexpr bool PERM = true, AFTER_DRAIN = false;
    bf16_t* O; const float* ss;
    __device__ __forceinline__ void operator()(f32x4 (&acc)[2][2][4][2], const Unit& u, int wr, int wc, int fr_, int fq_, int wid, int lane_) const {
        int fr = fr_, fq = fq_, lane = lane_; asm volatile("" : "+v"(fr), "+v"(fq), "+v"(lane));
        const int row0 = u.pm * BM + wr * 64 + fr, cin = wc * 32 + 8 * fq;
        const int mode = u.pn < 4 ? 0 : (u.pn < 8 ? 1 : 2);
        const int cbase = mode == 0 ? 128 * u.pn : (mode == 1 ? 1024 + 128 * (u.pn - 4) : 512 + 256 * (u.pn - 8));
        float rsv[2][4]; row_rstd8(ss, row0, fq, rsv);
#pragma unroll
        for (int ai = 0; ai < 2; ++ai)
#pragma unroll
            for (int m = 0; m < 4; ++m) { const int row = row0 + ai * HALF + m * 16; const float rs = rsv[ai][m];
                bf16_t* rowp = O + (size_t)row * 1536 + cbase + cin;
                f32x4 a0 = acc[ai][0][m][0] * rs, a1 = acc[ai][0][m][1] * rs, b0 = acc[ai][1][m][0] * rs, b1 = acc[ai][1][m][1] * rs;
                if (mode == 2) {
                    u32x4 w; w.x = cvt_pk_bf16(a0[0], a0[1]); w.y = cvt_pk_bf16(a0[2], a0[3]); w.z = cvt_pk_bf16(a1[0], a1[1]); w.w = cvt_pk_bf16(a1[2], a1[3]); *(u32x4*)rowp = w;
                    u32x4 x; x.x = cvt_pk_bf16(b0[0], b0[1]); x.y = cvt_pk_bf16(b0[2], b0[3]); x.z = cvt_pk_bf16(b1[0], b1[1]); x.w = cvt_pk_bf16(b1[2], b1[3]); *(u32x4*)(rowp + HALF) = x;
                } else {
                    if (mode == 0) {
#pragma unroll
                        for (int e = 0; e < 4; ++e) { b0[e] = sigm(b0[e]); b1[e] = sigm(b1[e]); } }
                    a0 = a0 * b0; a1 = a1 * b1;
                    u32x4 w; w.x = cvt_pk_bf16(a0[0], a0[1]); w.y = cvt_pk_bf16(a0[2], a0[3]); w.z = cvt_pk_bf16(a1[0], a1[1]); w.w = cvt_pk_bf16(a1[2], a1[3]); *(u32x4*)rowp = w;
                } }
    }
};
struct EpiRes {
    static constexpr bool PERM = true, AFTER_DRAIN = false;
    float* X; unsigned char* wsb; int use;
#if PROBE_OUT2 || PROBE_FF2X2
    int dry;
#endif
    __device__ __forceinline__ void operator()(f32x4 (&acc)[2][2][4][2], const Unit& u, int wr, int wc, int fr_, int fq_, int wid, int lane_) const {
        int fr = fr_, fq = fq_, lane = lane_; asm volatile("" : "+v"(fr), "+v"(fq), "+v"(lane));
#if PROBE_OUT2 || PROBE_FF2X2
        if (dry) return;
#endif
        if (u.split >= 0) {
            typedef unsigned long long u64;
            const int s = u.split, tt = (int)blockIdx.x / NS; float* part = (float*)(wsb + EPI_WS_PART); unsigned* cnt = (unsigned*)(wsb + EPI_WS_CNT) + use * 256 + tt * 8 + wid;
            u64* P = (u64*)(part + (((size_t)tt * NS + s) * 8 + wid) * 8192) + lane * 2;
#pragma unroll
            for (int q = 0; q < 4; ++q)
#pragma unroll
                for (int mm = 0; mm < 2; ++mm)
#pragma unroll
                    for (int bj = 0; bj < 2; ++bj)
#pragma unroll
                        for (int n = 0; n < 2; ++n) { const f32x4 v = acc[q >> 1][bj][2 * (q & 1) + mm][n]; u64* p = P + (q * 8 + (mm * 2 + bj) * 2 + n) * 128;
                            __hip_atomic_store(p, ((u64)__float_as_uint(v[1]) << 32) | __float_as_uint(v[0]), __ATOMIC_RELAXED, __HIP_MEMORY_SCOPE_AGENT);
                            __hip_atomic_store(p + 1, ((u64)__float_as_uint(v[3]) << 32) | __float_as_uint(v[2]), __ATOMIC_RELAXED, __HIP_MEMORY_SCOPE_AGENT); }
            asm volatile("s_waitcnt vmcnt(0)" ::: "memory");
            if (lane == 0) (void)__hip_atomic_fetch_add(cnt, 1u, __ATOMIC_RELAXED, __HIP_MEMORY_SCOPE_AGENT);
            return;
        }
        const int row0 = u.pm * BM + wr * 64 + fr, col0 = u.pn * BM + wc * 32 + 8 * fq;
        bf16_t* XB = (bf16_t*)(wsb + EPI_WS_XB); float* ssout = (float*)(wsb + EPI_WS_SS) + (size_t)(use + 1) * (18432 * 16);
        const float* xsrc = X - (u.pm < 64 ? 0 : (size_t)16384 * 1024) * 0;
        if (use == 0) { typedef const float* const __attribute__((address_space(4)))* KP; const KP ka = (KP)__builtin_amdgcn_kernarg_segment_ptr(); xsrc = (u.pm < 64) ? ka[0] : ka[1] - (size_t)16384 * 1024; }
#pragma unroll
        for (int ai = 0; ai < 2; ++ai)
#pragma unroll
            for (int m = 0; m < 4; ++m) { const int row = row0 + ai * HALF + m * 16; float sq = 0.f;
                float* xp = X + (size_t)row * 1024 + col0; bf16_t* bp = XB + (size_t)row * 1024 + col0;
                const float* sp_ = xsrc + (size_t)row * 1024 + col0;
#pragma unroll
                for (int bj = 0; bj < 2; ++bj) { const f32x4 x0 = *(const f32x4*)(sp_ + bj * HALF) + acc[ai][bj][m][0], x1 = *(const f32x4*)(sp_ + bj * HALF + 4) + acc[ai][bj][m][1];
                    *(f32x4*)(xp + bj * HALF) = x0; *(f32x4*)(xp + bj * HALF + 4) = x1;
                    sq += (x0[0] * x0[0] + x0[1] * x0[1]) + (x0[2] * x0[2] + x0[3] * x0[3]) + (x1[0] * x1[0] + x1[1] * x1[1]) + (x1[2] * x1[2] + x1[3] * x1[3]);
                    u32x4 w; w.x = cvt_pk_bf16(x0[0], x0[1]); w.y = cvt_pk_bf16(x0[2], x0[3]); w.z = cvt_pk_bf16(x1[0], x1[1]); w.w = cvt_pk_bf16(x1[2], x1[3]);
                    if (use != 7) *(u32x4*)(bp + bj * HALF) = w; }
                sq += __shfl_xor(sq, 16); sq += __shfl_xor(sq, 32);
                if (fq == 0) ssout[(size_t)row * 16 + u.pn * 4 + wc] = sq;
                if (m == 3) asm volatile("" ::: "memory"); }
    }
};
__device__ __forceinline__ void tail_job(float* X, unsigned char* wsb, int use, int job, int lane) {
    typedef unsigned long long u64;
    const int tt = job >> 5, w = (job >> 2) & 7, s = job & 3, wr = w >> 2, wc = w & 3, fr = lane & 15, fq = lane >> 4;
    float* part = (float*)(wsb + EPI_WS_PART); unsigned* cnt = (unsigned*)(wsb + EPI_WS_CNT) + use * 256 + tt * 8 + w;
    { unsigned spins = 0;
      while ((unsigned)__builtin_amdgcn_readfirstlane((int)__hip_atomic_load(cnt, __ATOMIC_RELAXED, __HIP_MEMORY_SCOPE_AGENT)) < (unsigned)NS) { __builtin_amdgcn_s_sleep(2); if (++spins > (1u << 22)) break; } }
    f32x4 v[2][2][2];
#pragma unroll
    for (int mm = 0; mm < 2; ++mm)
#pragma unroll
        for (int bj = 0; bj < 2; ++bj)
#pragma unroll
            for (int n = 0; n < 2; ++n) { f32x4 sum = (f32x4){0.f, 0.f, 0.f, 0.f};
#pragma unroll
                for (int sp = 0; sp < NS; ++sp) { const u64* qp = (const u64*)(part + (((size_t)tt * NS + sp) * 8 + w) * 8192) + lane * 2 + (s * 8 + (mm * 2 + bj) * 2 + n) * 128;
                    const u64 lo = __hip_atomic_load(qp, __ATOMIC_RELAXED, __HIP_MEMORY_SCOPE_AGENT), hi = __hip_atomic_load(qp + 1, __ATOMIC_RELAXED, __HIP_MEMORY_SCOPE_AGENT);
                    sum += (f32x4){__uint_as_float((unsigned)lo), __uint_as_float((unsigned)(lo >> 32)), __uint_as_float((unsigned)hi), __uint_as_float((unsigned)(hi >> 32))}; }
                v[mm][bj][n] = sum; }
    Unit u; StaticOrderT<4>::tile_of(256 + tt, u);
    const int ai = s >> 1, row0 = u.pm * BM + ai * HALF + wr * 64 + fr, col0 = u.pn * BM + wc * 32 + 8 * fq;
    bf16_t* XB = (bf16_t*)(wsb + EPI_WS_XB); float* ssout = (float*)(wsb + EPI_WS_SS) + (size_t)(use + 1) * (18432 * 16);
    const float* xsrc = X;
    if (use == 0) { typedef const float* const __attribute__((address_space(4)))* KP; const KP ka = (KP)__builtin_amdgcn_kernarg_segment_ptr(); xsrc = (u.pm < 64) ? ka[0] : ka[1] - (size_t)16384 * 1024; }
#pragma unroll
    for (int mm = 0; mm < 2; ++mm) { const int row = row0 + (2 * (s & 1) + mm) * 16; float sq = 0.f;
        float* xp = X + (size_t)row * 1024 + col0; bf16_t* bp = XB + (size_t)row * 1024 + col0; const float* sp_ = xsrc + (size_t)row * 1024 + col0;
#pragma unroll
        for (int bj = 0; bj < 2; ++bj) { const f32x4 x0 = *(const f32x4*)(sp_ + bj * HALF) + v[mm][bj][0], x1 = *(const f32x4*)(sp_ + bj * HALF + 4) + v[mm][bj][1];
            *(f32x4*)(xp + bj * HALF) = x0; *(f32x4*)(xp + bj * HALF + 4) = x1;
            sq += (x0[0] * x0[0] + x0[1] * x0[1]) + (x0[2] * x0[2] + x0[3] * x0[3]) + (x1[0] * x1[0] + x1[1] * x1[1]) + (x1[2] * x1[2] + x1[3] * x1[3]);
            u32x4 wv; wv.x = cvt_pk_bf16(x0[0], x0[1]); wv.y = cvt_pk_bf16(x0[2], x0[3]); wv.z = cvt_pk_bf16(x1[0], x1[1]); wv.w = cvt_pk_bf16(x1[2], x1[3]);
            if (use != 7) *(u32x4*)(bp + bj * HALF) = wv; }
        sq += __shfl_xor(sq, 16); sq += __shfl_xor(sq, 32);
        if (fq == 0) ssout[(size_t)row * 16 + u.pn * 4 + wc] = sq; }
}

template <class Epi, class Sched, bool ALIGN_EPI = false, bool SP2 = false>
__device__ __forceinline__ void gemm_phase(PG8_LAS unsigned char* lds, const Gemm g, const Sched& S, const Epi& E, const int tid_in) {
    const int tid = tid_in, wid = __builtin_amdgcn_readfirstlane(tid >> 6), lane = tid & 63, wr = wid >> 2, wc = wid & 3, fr = lane & 15, fq = lane >> 4;
    const int K = g.K;
    unsigned voffA[2], voffB[2];
#pragma unroll
    for (int i = 0; i < 2; ++i) { int R, C; stage_rc(tid * 16 + i * 8192, R, C); const int Rb = Epi::PERM ? ((R & ~31) + perm32(R & 31)) : R;
        voffA[i] = (unsigned)(R * K + C) * 2u; voffB[i] = (unsigned)(Rb * K + C) * 2u; }
    const size_t kstep = (size_t)(BK * 2);
    const size_t hstep = (size_t)HALF * K * 2;
    const size_t tstep = 2 * hstep;
    const unsigned ldsw = (unsigned)wid * 1024u;
    const int aoff = lds_byte(wr * 64 + fr, fq * 8), boff = lds_byte(wc * 32 + fr, fq * 8);
#define PG8_SA(b, h) (((b) * 2 + (h)) * HTB)
#define PG8_SB(b, h) ((4 + (b) * 2 + (h)) * HTB)
#define PG8_STAGE(bufoff, gbase, voff) do { _Pragma("unroll") for (int _i = 0; _i < 2; ++_i) \
        __builtin_amdgcn_global_load_lds((const unsigned*)((const char*)(gbase) + (voff)[_i]), (PG8_LAS unsigned*)(lds + (bufoff) + ldsw + _i * 8192), 16, 0, 0); } while (0)
#define PG8_LDA(dst, b, h) do { _Pragma("unroll") for (int m = 0; m < 4; ++m) _Pragma("unroll") for (int k = 0; k < 2; ++k) dst[m][k] = *(const PG8_LAS bf16x8*)(lds + PG8_SA(b, h) + aoff + m * 2048 + k * 1024); } while (0)
#define PG8_LDB(dst, b, h) do { _Pragma("unroll") for (int n = 0; n < 2; ++n) _Pragma("unroll") for (int k = 0; k < 2; ++k) dst[n][k] = *(const PG8_LAS bf16x8*)(lds + PG8_SB(b, h) + boff + n * 2048 + k * 1024); } while (0)
#define PG8_MMA(ai, bj, At, Bt) do { __builtin_amdgcn_s_setprio(1); _Pragma("unroll") for (int m = 0; m < 4; ++m) _Pragma("unroll") for (int n = 0; n < 2; ++n) _Pragma("unroll") for (int k = 0; k < 2; ++k) \
        acc[ai][bj][m][n] = __builtin_amdgcn_mfma_f32_16x16x32_bf16(Bt[n][k], At[m][k], acc[ai][bj][m][n], 0, 0, 0); __builtin_amdgcn_s_setprio(0); } while (0)
#define PG8_WAIT_V(n) asm volatile("s_waitcnt vmcnt(" #n ")" ::: "memory")
#define PG8_WAIT_L(n) asm volatile("s_waitcnt lgkmcnt(" #n ")" ::: "memory")
#define PG8_BAR __builtin_amdgcn_s_barrier()
#define PG8_SCHED __builtin_amdgcn_sched_barrier(0)
    Unit cur, nxt; int ui = 0;
    if (!S.next(0, cur)) return;
    f32x4 acc[2][2][4][2];
#pragma unroll
    for (int a = 0; a < 2; ++a)
#pragma unroll
        for (int b = 0; b < 2; ++b)
#pragma unroll
            for (int m = 0; m < 4; ++m)
#pragma unroll
                for (int n = 0; n < 2; ++n) acc[a][b][m][n] = (f32x4){0.f, 0.f, 0.f, 0.f};
    bf16x8 At[4][2], B0[2][2], B1[2][2];
    const char* cA = (const char*)g.A + (size_t)cur.pm * tstep + (size_t)cur.kt0 * kstep; const char* cB = (const char*)g.Bt + (size_t)cur.pn * tstep + (size_t)cur.kt0 * kstep;
    S.a_ready(cur);
    if constexpr (SP2) {
        PG8_STAGE(PG8_SB(0, 0), cB, voffB); PG8_STAGE(PG8_SB(0, 1), cB + hstep, voffB); PG8_STAGE(PG8_SA(0, 0), cA, voffA); PG8_STAGE(PG8_SA(0, 1), cA + hstep, voffA);
        if (wr == 1) PG8_BAR;
        PG8_WAIT_V(2); PG8_BAR;
        PG8_STAGE(PG8_SB(1, 0), cB + kstep, voffB); PG8_STAGE(PG8_SA(1, 0), cA + kstep, voffA); PG8_STAGE(PG8_SB(1, 1), cB + hstep + kstep, voffB);
        PG8_WAIT_V(6); PG8_BAR;
    } else {
        PG8_STAGE(PG8_SB(0, 0), cB, voffB); PG8_STAGE(PG8_SA(0, 0), cA, voffA); PG8_STAGE(PG8_SB(0, 1), cB + hstep, voffB); PG8_STAGE(PG8_SA(0, 1), cA + hstep, voffA);
        if (wr == 1) PG8_BAR;
        PG8_WAIT_V(4); PG8_BAR;
        PG8_STAGE(PG8_SB(1, 0), cB + kstep, voffB); PG8_STAGE(PG8_SA(1, 0), cA + kstep, voffA); PG8_STAGE(PG8_SB(1, 1), cB + hstep + kstep, voffB);
        PG8_WAIT_V(6); PG8_BAR;
    }
    for (;;) {
        const bool has_next = S.next(ui + 1, nxt);
        const char* nA = has_next ? (const char*)g.A + (size_t)nxt.pm * tstep + (size_t)nxt.kt0 * kstep : cA; const char* nB = has_next ? (const char*)g.Bt + (size_t)nxt.pn * tstep + (size_t)nxt.kt0 * kstep : cB;
        const int nt = cur.nkt;
        for (int t = 0; t < nt; t += 2) {
            const bool last = (t == nt - 2);
            const char* a1 = cA + (size_t)(t + 1) * kstep;
            const char* a2 = last ? nA : cA + (size_t)(t + 2) * kstep; const char* b2 = last ? nB : cB + (size_t)(t + 2) * kstep;
            const char* a3 = a2 + kstep; const char* b3 = b2 + kstep;
            if (last && has_next) S.a_ready(nxt);
            if constexpr (SP2) {
            PG8_LDB(B0, 0, 0); PG8_LDB(B1, 0, 1); PG8_SCHED; PG8_LDA(At, 0, 0); PG8_STAGE(PG8_SA(1, 1), a1 + hstep, voffA);
            PG8_WAIT_V(8); PG8_WAIT_L(0); PG8_BAR; PG8_MMA(0, 0, At, B0); PG8_MMA(0, 1, At, B1); PG8_BAR; PG8_SCHED;
            PG8_LDA(At, 0, 1); PG8_STAGE(PG8_SB(0, 0), b2, voffB); PG8_STAGE(PG8_SB(0, 1), b2 + hstep, voffB); PG8_STAGE(PG8_SA(0, 0), a2, voffA);
            PG8_WAIT_V(8); PG8_WAIT_L(0); PG8_BAR; PG8_MMA(1, 0, At, B0); PG8_MMA(1, 1, At, B1); PG8_BAR; PG8_SCHED;
            PG8_LDB(B0, 1, 0); PG8_LDB(B1, 1, 1); PG8_SCHED; PG8_LDA(At, 1, 0); PG8_STAGE(PG8_SA(0, 1), a2 + hstep, voffA);
            PG8_WAIT_V(8); PG8_WAIT_L(0); PG8_BAR; PG8_MMA(0, 0, At, B0); PG8_MMA(0, 1, At, B1); PG8_BAR; PG8_SCHED;
            PG8_LDA(At, 1, 1); PG8_STAGE(PG8_SB(1, 0), b3, voffB); PG8_STAGE(PG8_SB(1, 1), b3 + hstep, voffB); PG8_STAGE(PG8_SA(1, 0), a3, voffA);
            PG8_WAIT_V(8); PG8_WAIT_L(0); PG8_BAR; PG8_MMA(1, 0, At, B0); PG8_MMA(1, 1, At, B1); PG8_BAR; PG8_SCHED;
            } else {
            PG8_LDB(B0, 0, 0); PG8_SCHED; PG8_LDA(At, 0, 0); PG8_STAGE(PG8_SA(1, 1), a1 + hstep, voffA);
            PG8_WAIT_L(8); PG8_BAR; PG8_WAIT_L(0); PG8_MMA(0, 0, At, B0); PG8_BAR; PG8_SCHED;
            PG8_LDB(B1, 0, 1); PG8_STAGE(PG8_SB(0, 0), b2, voffB);
            PG8_BAR; PG8_WAIT_L(0); PG8_MMA(0, 1, At, B1); PG8_BAR;
            PG8_LDA(At, 0, 1); PG8_STAGE(PG8_SA(0, 0), a2, voffA);
            PG8_BAR; PG8_WAIT_L(0); PG8_MMA(1, 0, At, B0); PG8_BAR; PG8_SCHED;
            PG8_STAGE(PG8_SB(0, 1), b2 + hstep, voffB);
            PG8_WAIT_V(6); PG8_BAR; PG8_MMA(1, 1, At, B1); PG8_BAR;
            PG8_LDB(B0, 1, 0); PG8_SCHED; PG8_LDA(At, 1, 0); PG8_STAGE(PG8_SA(0, 1), a2 + hstep, voffA);
            PG8_WAIT_L(8); PG8_BAR; PG8_WAIT_L(0); PG8_MMA(0, 0, At, B0); PG8_BAR; PG8_SCHED;
            PG8_LDB(B1, 1, 1); PG8_STAGE(PG8_SB(1, 0), b3, voffB);
            PG8_BAR; PG8_WAIT_L(0); PG8_MMA(0, 1, At, B1); PG8_BAR;
            PG8_LDA(At, 1, 1); PG8_STAGE(PG8_SA(1, 0), a3, voffA);
            PG8_BAR; PG8_WAIT_L(0); PG8_MMA(1, 0, At, B0); PG8_BAR; PG8_SCHED;
            PG8_STAGE(PG8_SB(1, 1), b3 + hstep, voffB);
            PG8_WAIT_V(6); PG8_BAR; PG8_MMA(1, 1, At, B1); PG8_BAR;
            }
        }
        if constexpr (ALIGN_EPI) { if (wr == 0) PG8_BAR; }
        if constexpr (!Epi::AFTER_DRAIN) { E(acc, cur, wr, wc, fr, fq, wid, lane); S.done(cur); }
        if (!has_next) break;
#pragma unroll
        for (int a = 0; a < 2; ++a)
#pragma unroll
            for (int b = 0; b < 2; ++b)
#pragma unroll
                for (int m = 0; m < 4; ++m)
#pragma unroll
                    for (int n = 0; n < 2; ++n) acc[a][b][m][n] = (f32x4){0.f, 0.f, 0.f, 0.f};
        cur = nxt; cA = nA; cB = nB; ++ui;
        if constexpr (ALIGN_EPI) { if (wr == 1) PG8_BAR; }
    }
    PG8_WAIT_V(0);
    if constexpr (!ALIGN_EPI) { if (wr == 0) PG8_BAR; }
    PG8_BAR;
    if constexpr (Epi::AFTER_DRAIN) { E.fused(acc, cur, wr, wc, fr, fq, lds, wid, lane); S.done(cur); }
#undef PG8_SA
#undef PG8_SB
#undef PG8_STAGE
#undef PG8_LDA
#undef PG8_LDB
#undef PG8_MMA
#undef PG8_WAIT_V
#undef PG8_WAIT_L
#undef PG8_BAR
#undef PG8_SCHED
}
}

namespace cg = cooperative_groups;
#define GAS __attribute__((address_space(1)))
#define LAS __attribute__((address_space(3)))
typedef unsigned short bf16;
typedef unsigned v4u __attribute__((ext_vector_type(4)));
typedef unsigned v2u __attribute__((ext_vector_type(2)));
typedef float f32x4 __attribute__((ext_vector_type(4)));
typedef float f32x2 __attribute__((ext_vector_type(2)));
typedef short bf16x8 __attribute__((ext_vector_type(8)));

constexpr int NWAVES = 8, NTHR = 512;
constexpr int D = 1024, MP = 16384, MS = 2048, M = MP + MS, FF = 4096, EVEN_IN = 1536, ODD_IN = 2560, SEQ = 8192;
constexpr float EPS = 1e-6f;
constexpr int LDS_BYTES = 147456;
constexpr size_t MiB = 1u << 20;
constexpr size_t WS_SS = 206 * MiB;
constexpr size_t WS_WIN = 1 * MiB;
constexpr size_t WS_WOUT = 6 * MiB;
constexpr size_t WS_WFF1 = 10 * MiB;
constexpr size_t WS_WFF2 = 18 * MiB;
constexpr size_t WS_XB = 26 * MiB;
constexpr size_t WS_H = 62 * MiB;
constexpr size_t WS_Z = WS_H;
constexpr size_t WS_MIX = 152 * MiB;
constexpr size_t WS_PART = 218 * MiB;
constexpr size_t WS_CNT = 250 * MiB;
constexpr size_t CNT_BYTES = 8 * 256 * 4;
constexpr size_t WS_BAR = WS_CNT + CNT_BYTES;
constexpr size_t ZERO_BYTES = 24576;
constexpr size_t WS_VST = 251 * MiB;
constexpr size_t WS_END = 253 * MiB;
static_assert(pg8::NS == 4, "partial buffer sized for 4 slices");
static_assert(pg8::EPI_WS_XB == WS_XB && pg8::EPI_WS_SS == WS_SS && pg8::EPI_WS_PART == WS_PART && pg8::EPI_WS_CNT == WS_CNT, "epilogue view of the d_ws map");
constexpr size_t O_Y = 0, O_POOL_P = (size_t)M * D, O_CC_P = O_POOL_P + 2 * 2 * 15 * 512, O_CD_P = O_CC_P + 2 * 2 * 30 * 512, O_AV_S = O_CD_P + 2 * 2 * 2 * 512,
                 O_POOL_S = O_AV_S + (size_t)2 * 32 * 64 * 512, O_CC_S = O_POOL_S + 2 * 32 * 15 * 512, O_CD_S = O_CC_S + 2 * 32 * 30 * 512, O_END = O_CD_S + 2 * 32 * 2 * 512;
static_assert(O_END == 22607872, "output size");

__device__ __forceinline__ float wave_sum(float v) {
#pragma unroll
    for (int o = 1; o < 64; o <<= 1) v += __shfl_xor(v, o);
    return v;
}
__device__ __forceinline__ unsigned pk2(float lo, float hi) { return pg8::cvt_pk_bf16(lo, hi); }
__device__ __forceinline__ float bflo(unsigned w) { return __uint_as_float(w << 16); }
__device__ __forceinline__ float bfhi(unsigned w) { return __uint_as_float(w & 0xffff0000u); }
__device__ __forceinline__ void unpack8(const v4u w, f32x4& a, f32x4& b) { a = (f32x4){bflo(w.x), bfhi(w.x), bflo(w.y), bfhi(w.y)}; b = (f32x4){bflo(w.z), bfhi(w.z), bflo(w.w), bfhi(w.w)}; }
__device__ __forceinline__ v4u pack8(const f32x4 a, const f32x4 b) { v4u w; w.x = pk2(a[0], a[1]); w.y = pk2(a[2], a[3]); w.z = pk2(b[0], b[1]); w.w = pk2(b[2], b[3]); return w; }
__device__ __forceinline__ float sigmoidf_(float g) { return __builtin_amdgcn_rcpf(1.0f + __builtin_amdgcn_exp2f(g * -1.4426950409f)); }

__device__ __forceinline__ int odd_src_col(int n0) { const int p = n0 >> 8, hf = (n0 >> 7) & 1, j = n0 & 127; return p < 4 ? hf * 512 + 128 * p + j : (p < 8 ? 1536 + hf * 512 + 128 * (p - 4) + j : 1024 + (n0 - 2048)); }
__device__ __forceinline__ void cvt_item(const float* W, int K, int N, const float* gk, bf16* WT, LAS float* scr, int item, int lane, bool remap = false) {
    const int nblk = N / 32, kb = item / nblk, nb = item % nblk, k0 = 64 * kb, n0 = 32 * nb, s0 = remap ? odd_src_col(n0) : n0;
#pragma unroll 1
    for (int hb = 0; hb < 2; ++hb) {
        float wv[16]; const float* wp = W + (size_t)(k0 + 32 * hb + (lane >> 5)) * N + s0 + (lane & 31);
#pragma unroll
        for (int i = 0; i < 16; ++i) wv[i] = wp[(size_t)(2 * i) * N];
#pragma unroll
        for (int i = 0; i < 16; ++i) { const int kk = 32 * hb + 2 * i + (lane >> 5); float w = wv[i]; if (gk) w *= gk[k0 + kk]; scr[kk * 33 + (lane & 31)] = w; }
    }
    asm volatile("s_waitcnt lgkmcnt(0)" ::: "memory");
    const int c = lane & 7;
#pragma unroll
    for (int j = 0; j < 4; ++j) { const int n = (lane >> 3) + 8 * j; const LAS float* s = scr + (8 * c) * 33 + n;
        v4u o; o.x = pk2(s[0 * 33], s[1 * 33]); o.y = pk2(s[2 * 33], s[3 * 33]); o.z = pk2(s[4 * 33], s[5 * 33]); o.w = pk2(s[6 * 33], s[7 * 33]);
        *(v4u*)(WT + (size_t)(n0 + n) * K + k0 + 8 * c) = o; }
    asm volatile("s_waitcnt lgkmcnt(0)" ::: "memory");
}
__device__ __forceinline__ void fold_item(const float* Wo, const float* pw, const float* bs, bf16* WT, LAS float* scr, int item, int lane) {
    const int nb = item & 31, ch = (item >> 5) & 1, g = item >> 6, n0 = nb * 32, c = ch * 64 + lane;
    { const int n = lane & 31, dh = lane >> 5; const float* wp = Wo + (size_t)(512 + g * 128 + dh) * 1024 + n0 + n; const float* sp = bs + g * 128 + dh;
#pragma unroll 1
      for (int b = 0; b < 4; ++b) { float wv[16], sv[16];
#pragma unroll
          for (int i = 0; i < 16; ++i) { wv[i] = wp[(size_t)(2 * (b * 16 + i)) * 1024]; sv[i] = sp[2 * (b * 16 + i)]; }
#pragma unroll
          for (int i = 0; i < 16; ++i) scr[(2 * (b * 16 + i) + dh) * 32 + n] = wv[i] * sv[i]; } }
    asm volatile("s_waitcnt lgkmcnt(0)" ::: "memory");
    f32x4 acc[8];
#pragma unroll
    for (int i = 0; i < 8; ++i) acc[i] = (f32x4){0.f, 0.f, 0.f, 0.f};
    const float* pr = pw + ((size_t)g * 128 + c) * 128;
#pragma unroll 1
    for (int d0 = 0; d0 < 128; d0 += 32) { f32x4 pv[8];
#pragma unroll
        for (int j = 0; j < 8; ++j) pv[j] = *(const f32x4*)(pr + d0 + 4 * j);
#pragma unroll
        for (int j = 0; j < 8; ++j)
#pragma unroll
            for (int dd = 0; dd < 4; ++dd)
#pragma unroll
                for (int n4 = 0; n4 < 8; ++n4) { const f32x4 w = *(const LAS f32x4*)(scr + (d0 + 4 * j + dd) * 32 + n4 * 4); acc[n4] += w * pv[j][dd]; } }
#pragma unroll
    for (int n4 = 0; n4 < 8; ++n4)
#pragma unroll
        for (int e = 0; e < 4; ++e) WT[(size_t)(n0 + n4 * 4 + e) * 1024 + 512 + g * 128 + c] = (bf16)(pk2(acc[n4][e], 0.f) & 0xffffu);
    asm volatile("s_waitcnt lgkmcnt(0)" ::: "memory");
}

struct Args { const float* in[25]; float* out; unsigned char* ws; };
typedef const __attribute__((address_space(4))) Args* CArgs;
#define LAUNDER_V(x) asm volatile("" : "+v"(x))
#define LAUNDER_S(x) asm volatile("" : "+s"(x))

__device__ __forceinline__ int cvt_count(int kind, int layer) {
    if (kind == 0) return (layer & 1) ? 16 * (ODD_IN / 32) : 16 * (EVEN_IN / 32);
    if (kind == 1) return (layer & 1) ? 16 * 32 : 8 * 32 + 256;
    if (kind == 2) return 16 * (FF / 32);
    return (FF / 64) * 32;
}
__device__ __forceinline__ void cvt_do(CArgs A, int kind, int layer, int item, LAS float* scr, int lane) {
    unsigned char* ws = A->ws; const int i = layer >> 1;
    if (kind == 0) {
        if (layer & 1) cvt_item(A->in[16] + (size_t)i * D * ODD_IN, D, ODD_IN, A->in[5] + layer * D, (bf16*)(ws + WS_WIN), scr, item, lane, true);
        else cvt_item(A->in[8] + (size_t)i * D * EVEN_IN, D, EVEN_IN, A->in[5] + layer * D, (bf16*)(ws + WS_WIN), scr, item, lane);
    } else if (kind == 1) {
        bf16* wt = (bf16*)(ws + WS_WOUT + (size_t)(layer & 1) * 2 * MiB);
        if (layer & 1) cvt_item(A->in[17] + (size_t)i * D * D, D, D, nullptr, wt, scr, item, lane);
        else { if (item < 256) cvt_item(A->in[9] + (size_t)i * D * D, D, D, nullptr, wt, scr, item, lane);
               else fold_item(A->in[9] + (size_t)i * D * D, A->in[14] + (size_t)i * 4 * 128 * 128, A->in[15] + i * 512, wt, scr, item - 256, lane); }
    } else if (kind == 2) cvt_item(A->in[23] + (size_t)layer * D * FF, D, FF, A->in[6] + layer * D, (bf16*)(ws + WS_WFF1), scr, item, lane);
    else cvt_item(A->in[24] + (size_t)layer * FF * D, FF, D, nullptr, (bf16*)(ws + WS_WFF2), scr, item, lane);
}
__device__ __forceinline__ void cvt_run(CArgs A, int nk, int k0, int l0, int k1, int l1, int k2, int l2, int k3, int l3, LAS unsigned char* lds, int gw, int NGW, int wave, int lane) {
    LAS float* scr = (LAS float*)(lds + wave * 16384);
    const int c0 = cvt_count(k0, l0), c1 = nk > 1 ? cvt_count(k1, l1) : 0, c2 = nk > 2 ? cvt_count(k2, l2) : 0, c3 = nk > 3 ? cvt_count(k3, l3) : 0;
    const int tot = c0 + c1 + c2 + c3;
    for (int it = gw; it < tot; it += NGW) {
        int r = it;
        if (r < c0) { cvt_do(A, k0, l0, r, scr, lane); continue; } r -= c0;
        if (r < c1) { cvt_do(A, k1, l1, r, scr, lane); continue; } r -= c1;
        if (r < c2) { cvt_do(A, k2, l2, r, scr, lane); continue; } r -= c2;
        cvt_do(A, k3, l3, r, scr, lane);
    }
}

constexpr int VS_STRIDE = 66;
constexpr int ZE = 1536;
template <int WIN> __device__ __forceinline__ void pool_rows(const bf16* Z, bf16* MIX, const float* hist, float* pout, int rbase, int tfirst, int lr0, int colx, bool sample, bool lastchunk) {
    v4u x[WIN + 7];
#pragma unroll
    for (int k = 0; k < WIN + 7; ++k) { const int t = tfirst - WIN + 1 + k;
        if (t >= 0) x[k] = *(const v4u*)(Z + (size_t)(rbase + t) * ZE + 1024 + colx);
        else if (sample) { const float* hp = hist + (size_t)(15 + t) * 512; x[k] = pack8(*(const f32x4*)hp, *(const f32x4*)(hp + 4)); }
        else x[k] = (v4u){0u, 0u, 0u, 0u}; }
    f32x4 s0 = (f32x4){0.f, 0.f, 0.f, 0.f}, s1 = s0;
#pragma unroll
    for (int k = 0; k < WIN; ++k) { f32x4 a, b; unpack8(x[k], a, b); s0 += a; s1 += b; }
#pragma unroll
    for (int i = 0; i < 8; ++i) {
        const int t = tfirst + i; f32x4 xa, xb; unpack8(x[WIN - 1 + i], xa, xb);
        const int cnti = sample ? WIN : (t + 1 < WIN ? t + 1 : WIN);
        const float inv = 1.0f / (float)cnti;
        *(v4u*)(MIX + (size_t)(rbase + t) * D + 512 + colx) = pack8(s0 * inv - xa, s1 * inv - xb);
        if (lastchunk && lr0 + i >= 49) { float* po = pout + (size_t)(lr0 + i - 49) * 512; *(f32x4*)po = xa; *(f32x4*)(po + 4) = xb; }
        if (i < 7) { f32x4 na, nb, oa, ob; unpack8(x[WIN + i], na, nb); unpack8(x[i], oa, ob); s0 += na - oa; s1 += nb - ob; }
    }
}
__device__ __forceinline__ void even_unit(CArgs A, int ie, int q, LAS unsigned char* lds, int tid, int wave, int lane) {
    const bf16* Z = (const bf16*)(A->ws + WS_Z); bf16* MIX = (bf16*)(A->ws + WS_MIX); const float* VST = (const float*)(A->ws + WS_VST);
    const int row0 = q * 64; const bool sample = row0 >= MP;
    int t0, half, seq;
    if (!sample) { t0 = row0 & (SEQ - 1); half = (t0 >> 6) & 1; seq = row0 >> 13; } else { t0 = 0; half = 0; seq = (row0 - MP) >> 6; }
    const int nj = 64 * (half + 1), jrow0 = row0 - 64 * half, ioff = 64 * half;
    LAS f32x2* stat = (LAS f32x2*)(lds + 8 * 128 * VS_STRIDE * 2);
    LAS bf16* Vs = (LAS bf16*)lds + wave * 128 * VS_STRIDE;
    __syncthreads();
    if (tid < nj) {
        const float* vp = VST + (size_t)(jrow0 + tid) * 16;
        const f32x4 p0 = *(const f32x4*)vp, p1 = *(const f32x4*)(vp + 4), p2 = *(const f32x4*)(vp + 8), p3 = *(const f32x4*)(vp + 12);
        const float s = ((p0[0] + p0[2]) + (p1[0] + p1[2])) + ((p2[0] + p2[2]) + (p3[0] + p3[2])), qq = ((p0[1] + p0[3]) + (p1[1] + p1[3])) + ((p2[1] + p2[3]) + (p3[1] + p3[3]));
        const float mean = s * (1.0f / 512.0f), var = fmaxf(qq * (1.0f / 512.0f) - mean * mean, 0.f);
        stat[tid] = (f32x2){mean, __builtin_amdgcn_rsqf(var + EPS)};
    }
    __syncthreads();
    const int h = wave;
    {
        const int c8 = (lane & 7) * 8;
        const float* gp = A->in[12] + ie * 512 + h * 64 + c8; const float* bp = A->in[13] + ie * 512 + h * 64 + c8;
        const f32x4 g0 = *(const f32x4*)gp, g1 = *(const f32x4*)(gp + 4), b0 = *(const f32x4*)bp, b1 = *(const f32x4*)(bp + 4);
        for (int bb = 0; bb < nj / 64; ++bb) {
            v4u w[8];
#pragma unroll
            for (int i = 0; i < 8; ++i) w[i] = *(const v4u*)(Z + (size_t)(jrow0 + bb * 64 + i * 8 + (lane >> 3)) * ZE + 512 + h * 64 + c8);
#pragma unroll
            for (int i = 0; i < 8; ++i) {
                const int r = bb * 64 + i * 8 + (lane >> 3); f32x4 a, b; unpack8(w[i], a, b);
                const f32x2 st = stat[r];
                a = (a - st.x) * st.y * g0 + b0; b = (b - st.x) * st.y * g1 + b1;
                const v4u o = pack8(a, b);
                LAS unsigned* dst = (LAS unsigned*)(Vs + r * VS_STRIDE + c8);
                dst[0] = o.x; dst[1] = o.y; dst[2] = o.z; dst[3] = o.w;
                if (sample) { float* vo = A->out + O_AV_S + ((size_t)(ie * 32 + seq) * 64 + r) * 512 + h * 64 + c8; *(f32x4*)vo = a; *(f32x4*)(vo + 4) = b; }
            }
        }
    }
    asm volatile("s_waitcnt lgkmcnt(0)" ::: "memory");
    {
        const int fr = lane & 15, fq = lane >> 4;
        f32x4 acc[4][4];
#pragma unroll
        for (int a = 0; a < 4; ++a)
#pragma unroll
            for (int b = 0; b < 4; ++b) acc[a][b] = (f32x4){0.f, 0.f, 0.f, 0.f};
        const float* Wh = A->in[10] + ((size_t)(ie * 8 + h) * 128 + ioff) * 128 + (size_t)fr * 128 + 8 * fq;
        v2u uw[4][4]; float bias[4];
#pragma unroll
        for (int it = 0; it < 4; ++it) { bias[it] = A->in[11][(ie * 8 + h) * 128 + ioff + it * 16 + fr];
#pragma unroll
            for (int ct = 0; ct < 4; ++ct) uw[it][ct] = *(const v2u*)(Z + (size_t)(row0 + it * 16 + fr) * ZE + h * 64 + ct * 16 + 4 * fq); }
        f32x4 wn[4][2];
#pragma unroll
        for (int it = 0; it < 4; ++it) { wn[it][0] = *(const f32x4*)(Wh + it * 16 * 128); wn[it][1] = *(const f32x4*)(Wh + it * 16 * 128 + 4); }
        const int nks = nj / 32;
        for (int ks = 0; ks < nks; ++ks) {
            bf16x8 av[4], bv[4];
#pragma unroll
            for (int it = 0; it < 4; ++it) { const v4u pk = pack8(wn[it][0], wn[it][1]); bv[it] = __builtin_bit_cast(bf16x8, pk); }
            if (ks + 1 < nks) {
#pragma unroll
                for (int it = 0; it < 4; ++it) { wn[it][0] = *(const f32x4*)(Wh + it * 16 * 128 + (ks + 1) * 32); wn[it][1] = *(const f32x4*)(Wh + it * 16 * 128 + (ks + 1) * 32 + 4); } }
#pragma unroll
            for (int ct = 0; ct < 4; ++ct) {
                const LAS bf16* p = Vs + (ks * 32 + 8 * fq) * VS_STRIDE + ct * 16 + fr;
#pragma unroll
                for (int e = 0; e < 8; ++e) av[ct][e] = (short)p[e * VS_STRIDE];
            }
#pragma unroll
            for (int ct = 0; ct < 4; ++ct)
#pragma unroll
                for (int it = 0; it < 4; ++it) acc[ct][it] = __builtin_amdgcn_mfma_f32_16x16x32_bf16(av[ct], bv[it], acc[ct][it], 0, 0, 0);
        }
#pragma unroll
        for (int it = 0; it < 4; ++it) {
            const int row = row0 + it * 16 + fr;
#pragma unroll
            for (int ct = 0; ct < 4; ++ct) {
                const int col = h * 64 + ct * 16 + 4 * fq;
                const f32x4 uu = (f32x4){bflo(uw[it][ct].x), bfhi(uw[it][ct].x), bflo(uw[it][ct].y), bfhi(uw[it][ct].y)};
                const f32x4 y = uu * (acc[ct][it] + bias[it]);
                v2u o; o.x = pk2(y[0], y[1]); o.y = pk2(y[2], y[3]);
                *(v2u*)(MIX + (size_t)row * D + col) = o;
            }
        }
    }
    {
        const int g = wave & 3, rh = wave >> 2, cb = lane & 15, rs = lane >> 4;
        const int colx = g * 128 + cb * 8;
        const int rbase = row0 - t0;
        const bool lastchunk = sample || (t0 == SEQ - 64);
        const float* hist = A->in[2] + ((size_t)(ie * 32 + seq) * 15) * 512 + colx;
        float* pout = sample ? (A->out + O_POOL_S + ((size_t)(ie * 32 + seq) * 15) * 512 + colx) : (A->out + O_POOL_P + ((size_t)(ie * 2 + seq) * 15) * 512 + colx);
        const int lr0 = 32 * rh + 8 * rs, tfirst = t0 + lr0;
        if (g == 0) pool_rows<2>(Z, MIX, hist, pout, rbase, tfirst, lr0, colx, sample, lastchunk);
        else if (g == 1) pool_rows<4>(Z, MIX, hist, pout, rbase, tfirst, lr0, colx, sample, lastchunk);
        else if (g == 2) pool_rows<8>(Z, MIX, hist, pout, rbase, tfirst, lr0, colx, sample, lastchunk);
        else pool_rows<16>(Z, MIX, hist, pout, rbase, tfirst, lr0, colx, sample, lastchunk);
    }
}

__device__ __forceinline__ void odd_unit(CArgs A, int io, int q, LAS unsigned char* lds, int tid, int wave, int lane) {
    const bf16* Z = (const bf16*)(A->ws + WS_Z); bf16* MIX = (bf16*)(A->ws + WS_MIX);
    const int row0 = q * 64; const bool sample = row0 >= MP;
    int t0, seq;
    if (!sample) { t0 = row0 & (SEQ - 1); seq = row0 >> 13; } else { t0 = 0; seq = (row0 - MP) >> 6; }
    const int rbase = row0 - t0; const int T = sample ? 64 : SEQ; const bool lastchunk = sample || (t0 == SEQ - 64);
    LAS bf16* cin = (LAS bf16*)lds;
    LAS float* cbuf = (LAS float*)(lds + 94 * 1024);
    {
        const int cb = tid & 63, rg = tid >> 6, ch = cb * 8;
        const float* dw = A->in[22] + (size_t)io * 3 * 512 + ch;
        const f32x4 w0a = *(const f32x4*)dw, w0b = *(const f32x4*)(dw + 4), w1a = *(const f32x4*)(dw + 512), w1b = *(const f32x4*)(dw + 516), w2a = *(const f32x4*)(dw + 1024), w2b = *(const f32x4*)(dw + 1028);
        const float* hd = A->in[4] + ((size_t)(io * 32 + seq) * 2) * 512 + ch;
        float* dout = sample ? (A->out + O_CD_S + ((size_t)(io * 32 + seq) * 2) * 512 + ch) : (A->out + O_CD_P + ((size_t)(io * 2 + seq) * 2) * 512 + ch);
        const int tf = t0 + 8 * rg;
        v4u dgw[10], gbw[8];
#pragma unroll
        for (int k = 0; k < 10; ++k) { const int t = tf - 2 + k;
            if (t >= 0) dgw[k] = *(const v4u*)(Z + (size_t)(rbase + t) * ZE + 1024 + ch);
            else if (sample) { const float* hp = hd + (size_t)(2 + t) * 512; dgw[k] = pack8(*(const f32x4*)hp, *(const f32x4*)(hp + 4)); }
            else dgw[k] = (v4u){0u, 0u, 0u, 0u}; }
#pragma unroll
        for (int i = 0; i < 8; ++i) gbw[i] = *(const v4u*)(Z + (size_t)(rbase + tf + i) * ZE + 512 + ch);
        f32x4 m2a, m2b, m1a, m1b; unpack8(dgw[0], m2a, m2b); unpack8(dgw[1], m1a, m1b);
#pragma unroll
        for (int i = 0; i < 8; ++i) {
            const int t = tf + i; f32x4 da, db, ga, gb; unpack8(dgw[2 + i], da, db); unpack8(gbw[i], ga, gb);
            const f32x4 ya = ga * (w0a * m2a + w1a * m1a + w2a * da), yb = gb * (w0b * m2b + w1b * m1b + w2b * db);
            *(v4u*)(MIX + (size_t)(rbase + t) * D + 512 + ch) = pack8(ya, yb);
            const int lr = 8 * rg + i;
            if (lastchunk && lr >= 62) { float* po = dout + (size_t)(lr - 62) * 512; *(f32x4*)po = da; *(f32x4*)(po + 4) = db; }
            m2a = m1a; m2b = m1b; m1a = da; m1b = db;
        }
    }
    __syncthreads();
    {
        const float* hc = A->in[3] + ((size_t)(io * 32 + seq) * 30) * 512;
        float* cout = sample ? (A->out + O_CC_S + ((size_t)(io * 32 + seq) * 30) * 512) : (A->out + O_CC_P + ((size_t)(io * 2 + seq) * 30) * 512);
        for (int base = tid; base < 94 * 64; base += 4 * NTHR) {
            v4u w[4];
#pragma unroll
            for (int u = 0; u < 4; ++u) { const int item = base + u * NTHR, lr = item >> 6, cb = item & 63, t = t0 + lr - 30;
                if (item < 94 * 64 && t >= 0) w[u] = *(const v4u*)(Z + (size_t)(rbase + t) * ZE + cb * 8);
                else if (item < 94 * 64 && sample) { const float* hp = hc + (size_t)(30 + t) * 512 + cb * 8; w[u] = pack8(*(const f32x4*)hp, *(const f32x4*)(hp + 4)); }
                else w[u] = (v4u){0u, 0u, 0u, 0u}; }
#pragma unroll
            for (int u = 0; u < 4; ++u) { const int item = base + u * NTHR, lr = item >> 6, cb = item & 63, t = t0 + lr - 30;
                if (item < 94 * 64) {
                    *(LAS v4u*)(cin + lr * 512 + cb * 8) = w[u];
                    if (lastchunk && lr >= 30 && t >= T - 30) { f32x4 a, b; unpack8(w[u], a, b); float* po = cout + (size_t)(t - (T - 30)) * 512 + cb * 8; *(f32x4*)po = a; *(f32x4*)(po + 4) = b; } } }
        }
    }
    __syncthreads();
    {
        const int cp = tid & 255, rq = tid >> 8;
        f32x2 w[31];
#pragma unroll
        for (int k = 0; k < 31; ++k) w[k] = *(const f32x2*)(A->in[18] + ((size_t)io * 31 + k) * 512 + 2 * cp);
        const f32x2 cbias = *(const f32x2*)(A->in[19] + io * 512 + 2 * cp);
        const float* lg = A->in[20] + io * 512 + lane * 8; const float* lb = A->in[21] + io * 512 + lane * 8;
        const f32x4 g0 = *(const f32x4*)lg, g1 = *(const f32x4*)(lg + 4), b0 = *(const f32x4*)lb, b1 = *(const f32x4*)(lb + 4);
        for (int sb = 0; sb < 4; ++sb) {
            const int r0 = 16 * sb + 8 * rq;
            f32x2 acc[8];
#pragma unroll
            for (int i = 0; i < 8; ++i) acc[i] = cbias;
#pragma unroll
            for (int j = 0; j < 38; ++j) { const unsigned xw = *(const LAS unsigned*)(cin + (r0 + j) * 512 + 2 * cp); const f32x2 x = (f32x2){bflo(xw), bfhi(xw)};
#pragma unroll
                for (int i = 0; i < 8; ++i) { if (j - i >= 0 && j - i < 31) acc[i] += w[j - i] * x; } }
#pragma unroll
            for (int i = 0; i < 8; ++i) *(LAS f32x2*)(cbuf + (8 * rq + i) * 512 + 2 * cp) = acc[i];
            __syncthreads();
#pragma unroll
            for (int rr = 0; rr < 2; ++rr) {
                const int lr = 2 * wave + rr;
                f32x4 a = *(const LAS f32x4*)(cbuf + lr * 512 + lane * 8), b = *(const LAS f32x4*)(cbuf + lr * 512 + lane * 8 + 4);
                const float s = wave_sum((a[0] + a[1]) + (a[2] + a[3]) + (b[0] + b[1]) + (b[2] + b[3]));
                const float mean = s * (1.0f / 512.0f);
                a = a - mean; b = b - mean;
                const float qq = wave_sum((a[0] * a[0] + a[1] * a[1]) + (a[2] * a[2] + a[3] * a[3]) + (b[0] * b[0] + b[1] * b[1]) + (b[2] * b[2] + b[3] * b[3]));
                const float rstd = __builtin_amdgcn_rsqf(qq * (1.0f / 512.0f) + EPS);
                a = a * rstd * g0 + b0; b = b * rstd * g1 + b1;
#pragma unroll
                for (int e = 0; e < 4; ++e) { a[e] = a[e] * sigmoidf_(a[e]); b[e] = b[e] * sigmoidf_(b[e]); }
                *(v4u*)(MIX + (size_t)(row0 + 16 * sb + lr) * D + lane * 8) = pack8(a, b);
            }
            __syncthreads();
        }
    }
}

#define RLX_AGENT __ATOMIC_RELAXED, __HIP_MEMORY_SCOPE_AGENT
#define XB_TMO      128
#define XB_XCNT(j)  (256  + 64 * (j))
#define XB_XSUB(j)  (1280 + 64 * (j))
#define XB_XGEN(j)  (2304 + 64 * (j))
#define XB_TOP      3328
#define XB_TOPGEN   3392
#define XCD_BAR_WORDS 3456
#define XB_SPIN_CAP (1u << 18)

__device__ __forceinline__ unsigned xb_ld(unsigned* p)              { return __hip_atomic_load(p, __ATOMIC_RELAXED, __HIP_MEMORY_SCOPE_AGENT); }
__device__ __forceinline__ unsigned xb_add(unsigned* p, unsigned v) { return __hip_atomic_fetch_add(p, v, __ATOMIC_RELAXED, __HIP_MEMORY_SCOPE_AGENT); }
__device__ __forceinline__ unsigned xb_xcc_id() { return (unsigned)__builtin_amdgcn_s_getreg((3 << 11) | 20) & 0xFu; }
#define XB_SPIN(cond, bar) do { unsigned _sp = 0; while (cond) { __builtin_amdgcn_s_sleep(1); \
    if ((++_sp & 255u) == 0u) { if (xb_ld(&(bar)[XB_TMO])) break; if (_sp > XB_SPIN_CAP) { atomicAdd(&(bar)[XB_TMO], 1u); break; } } } } while (0)

struct XcdBarrier {
    unsigned* bar; unsigned x;
    volatile LAS unsigned* st;
};

__device__ __forceinline__ XcdBarrier xcd_barrier_post(unsigned* bar, volatile LAS unsigned* st) {
    XcdBarrier b; b.bar = bar; b.x = xb_xcc_id(); b.st = st;
    if (threadIdx.x == 0) (void)xb_add(&bar[XB_XCNT(b.x)], 1u);
    return b;
}
__device__ __forceinline__ void xcd_barrier_complete(unsigned* bar, unsigned x, unsigned& nloc, unsigned& nx) {
    const unsigned G = gridDim.x * gridDim.y * gridDim.z;
    unsigned sum, cnt, mine, sp = 0u;
    for (;;) {
        sum = 0u; cnt = 0u; mine = 0u;
#pragma unroll
        for (unsigned j = 0; j < 16; ++j) { const unsigned c = xb_ld(&bar[XB_XCNT(j)]); sum += c; cnt += (c > 0u) ? 1u : 0u; mine = (j == x) ? c : mine; }
        if (sum == G) break;
        __builtin_amdgcn_s_sleep(1);
        if ((++sp & 255u) == 0u) { if (xb_ld(&bar[XB_TMO])) break; if (sp > XB_SPIN_CAP) { atomicAdd(&bar[XB_TMO], 1u); break; } }
    }
    nloc = mine > 0u ? mine : 1u; nx = cnt > 0u ? cnt : 1u;
}

__device__ __forceinline__ void xcd_barrier(const XcdBarrier& b) {
    asm volatile("s_waitcnt vmcnt(0)" ::: "memory");
    __syncthreads();
    if (threadIdx.x == 0) {
        unsigned* bar = b.bar;
        __builtin_amdgcn_s_waitcnt(0);
        unsigned nloc = b.st[0], nx = b.st[1];
        if (nloc == 0u) { xcd_barrier_complete(bar, b.x, nloc, nx); b.st[0] = nloc; b.st[1] = nx; }
        const unsigned old = xb_add(&bar[XB_XSUB(b.x)], 1u);
        const unsigned gen = old / nloc;
        if (old + 1u == (gen + 1u) * nloc) {
            __builtin_amdgcn_fence(__ATOMIC_RELEASE, "agent");
            asm volatile("s_waitcnt vmcnt(0)" ::: "memory");
            const unsigned og = xb_add(&bar[XB_TOP], 1u);
            const unsigned tg = og / nx;
            if (og + 1u == (tg + 1u) * nx) xb_add(&bar[XB_TOPGEN], 1u);
            else XB_SPIN(xb_ld(&bar[XB_TOPGEN]) == tg, bar);
            __builtin_amdgcn_fence(__ATOMIC_ACQUIRE, "agent");
            xb_add(&bar[XB_XGEN(b.x)], 1u);
            asm volatile("s_waitcnt vmcnt(0)" ::: "memory");
        } else {
            XB_SPIN(xb_ld(&bar[XB_XGEN(b.x)]) == gen, bar);
            __builtin_amdgcn_fence(__ATOMIC_ACQUIRE, "agent");
            asm volatile("s_waitcnt vmcnt(0)" ::: "memory");
        }
    }
    __syncthreads();
}

__global__ void __launch_bounds__(NTHR, 2) fwd_megakernel(Args A_unused) {
    extern __shared__ __attribute__((aligned(16))) unsigned char lds_raw[];
    LAS unsigned char* lds = (LAS unsigned char*)lds_raw;
    cg::grid_group grid = cg::this_grid();
    const CArgs A0 = (CArgs)__builtin_amdgcn_kernarg_segment_ptr();
    const int G = gridDim.x, bx = blockIdx.x;
    volatile LAS unsigned* xst = (volatile LAS unsigned*)(lds + LDS_BYTES - 64);
    if (threadIdx.x < 2) xst[threadIdx.x] = 0u;
    __syncthreads();
    const XcdBarrier xbar = xcd_barrier_post((unsigned*)(A0->ws + WS_BAR), xst);
#define GRID_SYNC1() xcd_barrier(xbar)
#define GRID_SYNC_CG() do { asm volatile("s_waitcnt vmcnt(0) lgkmcnt(0)" ::: "memory"); grid.sync(); } while (0)
#if PROBE_SYNC2
#define GRID_SYNC() do { GRID_SYNC1(); GRID_SYNC1(); } while (0)
#else
#define GRID_SYNC() GRID_SYNC1()
#endif
#define GRID_SYNC_UNUSED() do { } while (0)
#define PHASE_BEGIN() CArgs A = A0; LAUNDER_S(A); int tid = threadIdx.x; LAUNDER_V(tid); const int lane = tid & 63, wave = __builtin_amdgcn_readfirstlane(tid >> 6); const int gw = bx * NWAVES + wave, NGW = G * NWAVES; \
    unsigned char* ws = A->ws; float* X = A->out + O_Y; float* SS = (float*)(ws + WS_SS); bf16* XB = (bf16*)(ws + WS_XB); (void)lane; (void)gw; (void)NGW; (void)X; (void)SS; (void)XB

    {
        PHASE_BEGIN();
        cvt_run(A, 2, 0, 0, 1, 0, 0, 0, 0, 0, lds, gw, NGW, wave, lane);
        for (int m0 = gw; m0 < M; m0 += 3 * NGW) {
            f32x4 v[3][4];
#pragma unroll
            for (int r = 0; r < 3; ++r) { const int m = m0 + r * NGW; if (m < M) { const float* src = (m < MP) ? (A->in[0] + (size_t)m * D) : (A->in[1] + (size_t)(m - MP) * D);
#pragma unroll
                for (int j = 0; j < 4; ++j) v[r][j] = *(const f32x4*)(src + (lane + 64 * j) * 4); } }
#pragma unroll
            for (int r = 0; r < 3; ++r) { const int m = m0 + r * NGW; if (m < M) { float s2 = 0.f;
#pragma unroll
                for (int j = 0; j < 4; ++j) { s2 += (v[r][j][0] * v[r][j][0] + v[r][j][1] * v[r][j][1]) + (v[r][j][2] * v[r][j][2] + v[r][j][3] * v[r][j][3]);
                    v2u o; o.x = pk2(v[r][j][0], v[r][j][1]); o.y = pk2(v[r][j][2], v[r][j][3]); *(v2u*)(XB + (size_t)m * D + (lane + 64 * j) * 4) = o; }
                s2 = wave_sum(s2);
                if (lane < 4) *(f32x4*)(SS + (size_t)m * 16 + lane * 4) = (f32x4){lane == 0 ? s2 : 0.f, 0.f, 0.f, 0.f}; } }
        }
    }
    GRID_SYNC_CG();

#pragma unroll 1
    for (int layer = 0; layer < 4; ++layer) {
        const int i2 = layer >> 1; const bool odd = layer & 1;
#pragma unroll 1
        for (int rep = 0; rep < 1 + PROBE_IN2; ++rep) {
        if (!odd) { PHASE_BEGIN(); pg8::Gemm g{XB, (const bf16*)(ws + WS_WIN), M, EVEN_IN, D}; pg8::StaticOrderT<6> S; S.init(D, G, bx);
            pg8::EpiAct<0> E{(bf16*)(ws + WS_Z), EVEN_IN, SS + (size_t)(2 * layer) * M * 16, (float*)(ws + WS_VST)};
            pg8::gemm_phase<pg8::EpiAct<0>, pg8::StaticOrderT<6>, true, true>(lds, g, S, E, tid); }
        else { PHASE_BEGIN(); pg8::Gemm g{XB, (const bf16*)(ws + WS_WIN), M, ODD_IN, D}; pg8::StaticOrderT<10> S; S.init(D, G, bx);
            pg8::EpiOdd E{(bf16*)(ws + WS_Z), SS + (size_t)(2 * layer) * M * 16};
            pg8::gemm_phase<pg8::EpiOdd, pg8::StaticOrderT<10>, true, true>(lds, g, S, E, tid); } }
        GRID_SYNC();
#pragma unroll 1
        for (int rep = 0; rep < 1 + PROBE_MIX2; ++rep) {
        if (!odd) { PHASE_BEGIN(); for (int q = bx; q < M / 64; q += G) even_unit(A, i2, q, lds, tid, wave, lane); }
        else { PHASE_BEGIN(); for (int q = bx; q < M / 64; q += G) odd_unit(A, i2, q, lds, tid, wave, lane); }
        __syncthreads(); }
#pragma unroll 1
        for (int rep = 0; rep < 1 + PROBE_CVT2; ++rep)
        { PHASE_BEGIN();
          const bool skew = (G == 256); const int cgw = skew ? gw - 32 * NWAVES : gw, cng = skew ? NGW - 32 * NWAVES : NGW;
          if (cgw >= 0 && layer == 0) cvt_run(A, 1, 2, 0, 0, 0, 0, 0, 0, 0, lds, cgw, cng, wave, lane); }
        GRID_SYNC();
#pragma unroll 1
        for (int rep = 0; rep < 1 + PROBE_OUT2; ++rep)
        { PHASE_BEGIN(); pg8::Gemm g{(const bf16*)(ws + WS_MIX), (const bf16*)(ws + WS_WOUT + (size_t)(layer & 1) * 2 * MiB), M, D, D}; pg8::EpiRes E{X, ws, 2 * layer};
#if PROBE_OUT2 || PROBE_FF2X2
          E.dry = rep < PROBE_OUT2;
#endif

          if (G == 256) { pg8::TailOrder256 S; S.init(D, G, bx); pg8::gemm_phase<pg8::EpiRes, pg8::TailOrder256, true, true>(lds, g, S, E, tid); }
          else { pg8::StaticOrderT<4> S; S.init(D, G, bx); pg8::gemm_phase<pg8::EpiRes, pg8::StaticOrderT<4>, true, true>(lds, g, S, E, tid); } }
        { PHASE_BEGIN();
          if (G == 256 && bx >= 128) pg8::tail_job(X, ws, 2 * layer, (bx - 128) * NWAVES + wave, lane);
          const bool skew = (G == 256); const int cgw = skew ? gw - 128 * NWAVES : gw, cng = skew ? NGW - 128 * NWAVES : NGW;
          if (cgw >= 0) { if (layer < 3) cvt_run(A, 2, 3, layer, 0, layer + 1, 0, 0, 0, 0, lds, cgw, cng, wave, lane); else cvt_run(A, 1, 3, layer, 0, 0, 0, 0, 0, 0, lds, cgw, cng, wave, lane); } }
        GRID_SYNC();
#pragma unroll 1
        for (int rep = 0; rep < 1 + PROBE_FF1X2; ++rep)
        { PHASE_BEGIN(); pg8::Gemm g{XB, (const bf16*)(ws + WS_WFF1), M, FF, D}; pg8::StaticOrderT<16> S; S.init(D, G, bx);
          pg8::EpiAct<2> E{(bf16*)(ws + WS_H), FF, SS + (size_t)(2 * layer + 1) * M * 16, nullptr};
          pg8::gemm_phase<pg8::EpiAct<2>, pg8::StaticOrderT<16>, true, true>(lds, g, S, E, tid); }
        GRID_SYNC();
#pragma unroll 1
        for (int rep = 0; rep < 1 + PROBE_FF2X2; ++rep)
        { PHASE_BEGIN(); pg8::Gemm g{(const bf16*)(ws + WS_H), (const bf16*)(ws + WS_WFF2), M, D, FF}; pg8::EpiRes E{X, ws, 2 * layer + 1};
#if PROBE_OUT2 || PROBE_FF2X2
          E.dry = rep < PROBE_FF2X2;
#endif

          if (G == 256) { pg8::TailOrder256 S; S.init(FF, G, bx); pg8::gemm_phase<pg8::EpiRes, pg8::TailOrder256, true, true>(lds, g, S, E, tid); }
          else { pg8::StaticOrderT<4> S; S.init(FF, G, bx); pg8::gemm_phase<pg8::EpiRes, pg8::StaticOrderT<4>, true, true>(lds, g, S, E, tid); } }
        { PHASE_BEGIN(); if (G == 256 && bx >= 128) pg8::tail_job(X, ws, 2 * layer + 1, (bx - 128) * NWAVES + wave, lane); }
        if (layer < 3) { PHASE_BEGIN();
          const bool skew = (G == 256); const int cgw = skew ? gw - 128 * NWAVES : gw, cng = skew ? NGW - 128 * NWAVES : NGW;
          if (cgw >= 0) cvt_run(A, 2, 1, layer + 1, 2, layer + 1, 0, 0, 0, 0, lds, cgw, cng, wave, lane); }
        GRID_SYNC();
    }
    {
        PHASE_BEGIN();
        const float* fg = A->in[7]; const float* ss = SS + (size_t)8 * M * 16;
        f32x4 gv[4];
#pragma unroll
        for (int j = 0; j < 4; ++j) gv[j] = *(const f32x4*)(fg + (lane + 64 * j) * 4);
        for (int m0 = gw; m0 < M; m0 += 3 * NGW) {
            f32x4 v[3][4]; float sp[3];
#pragma unroll
            for (int r = 0; r < 3; ++r) { const int m = m0 + r * NGW; if (m < M) { sp[r] = lane < 16 ? ss[(size_t)m * 16 + lane] : 0.f;
#pragma unroll
                for (int j = 0; j < 4; ++j) v[r][j] = *(const f32x4*)(X + (size_t)m * D + (lane + 64 * j) * 4); } }
#pragma unroll
            for (int r = 0; r < 3; ++r) { const int m = m0 + r * NGW; if (m < M) { const float rs = __builtin_amdgcn_rsqf(wave_sum(sp[r]) * (1.0f / 1024.0f) + EPS);
#pragma unroll
                for (int j = 0; j < 4; ++j) *(f32x4*)(X + (size_t)m * D + (lane + 64 * j) * 4) = v[r][j] * rs * gv[j]; } }
        }
    }
}

extern "C" void kernel_launch(void* const* d_in, const int* in_sizes, int n_in, void* d_out, int out_size, void* d_ws, size_t ws_size, hipStream_t stream) {
    static int grid = 0;
    if (grid == 0) {
        if (n_in != 25 || (size_t)out_size != O_END || ws_size < WS_END) { fprintf(stderr, "kernel_launch: unexpected shapes (n_in %d out %d ws %zu)\n", n_in, out_size, ws_size); grid = -1; return; }
        int dev = 0, cus = 0, per_cu = 0;
        (void)hipGetDevice(&dev); (void)hipDeviceGetAttribute(&cus, hipDeviceAttributeMultiprocessorCount, dev);
        (void)hipFuncSetAttribute((const void*)fwd_megakernel, hipFuncAttributeMaxDynamicSharedMemorySize, LDS_BYTES);
        (void)hipOccupancyMaxActiveBlocksPerMultiprocessor(&per_cu, (const void*)fwd_megakernel, NTHR, LDS_BYTES);
        (void)hipGetLastError();
        if (per_cu < 1) per_cu = 1;
        grid = cus * per_cu;
        fprintf(stderr, "kernel_launch: cus %d per_cu %d grid %d ws %zu\n", cus, per_cu, grid, ws_size);
    }
    if (grid < 0) return;
    (void)hipMemsetAsync((unsigned char*)d_ws + WS_CNT, 0, ZERO_BYTES, stream);
    Args a{};
    for (int i = 0; i < 25; ++i) a.in[i] = (const float*)d_in[i];
    a.out = (float*)d_out; a.ws = (unsigned char*)d_ws;
    void* args[] = {&a};
    hipError_t e = hipLaunchCooperativeKernel((const void*)fwd_megakernel, dim3(grid), dim3(NTHR), args, LDS_BYTES, stream);
    if (e != hipSuccess) fprintf(stderr, "cooperative launch failed: %s (grid %d)\n", hipGetErrorString(e), grid);
}
```

```cpp
#include <hip/hip_runtime.h>
#include <hip/hip_cooperative_groups.h>
#include <cstdio>
#include <cstdint>
#ifndef PROBE_SYNC2
#define PROBE_SYNC2 0
#define PROBE_MIX2 0
#define PROBE_CVT2 0
#define PROBE_FF1X2 0
#define PROBE_IN2 0
#define PROBE_OUT2 0
#define PROBE_FF2X2 0
#endif
namespace pg8 {
#define PG8_LAS __attribute__((address_space(3)))
typedef unsigned short bf16_t;
typedef short bf16x8 __attribute__((ext_vector_type(8)));
typedef float f32x4 __attribute__((ext_vector_type(4)));
typedef unsigned u32x4 __attribute__((ext_vector_type(4)));
constexpr int BM = 256, BK = 64, HALF = 128, HTB = HALF * BK * 2  , STAGE_BYTES = 8 * HTB, NXCD = 8, WGM = 8;

__host__ __device__ __forceinline__ int lds_byte(int r, int c) { const int st = (r >> 4) * 2 + (c >> 5), rr = r & 15, cc = c & 31, ob = rr * 64 + cc * 2; return st * 1024 + (ob ^ (((ob >> 9) & 1) << 5)); }
__host__ __device__ __forceinline__ void stage_rc(int b, int& R, int& C) { const int st = b / 1024, sb = b % 1024, swz = sb ^ (((sb >> 9) & 1) << 5); R = (st >> 1) * 16 + swz / 64; C = (st & 1) * 32 + (swz % 64) / 2; }
__host__ __device__ __forceinline__ int perm32(int rho) { const int n = rho >> 4, i = rho & 15; return 8 * (i >> 2) + 4 * n + (i & 3); }

struct Unit { int pm, pn, kt0, nkt, split; };
struct Gemm { const bf16_t* A; const bf16_t* Bt; int M, N, K; };

template <int NN> struct StaticOrderT {
    static constexpr int nM = 72, nN = NN, nwg = nM * nN, nkt_unused = 0;
    int G, c, nkt;
    __host__ __device__ void init(int K, int G_, int c_) { G = G_; c = c_; nkt = K / BK; }
    __host__ __device__ static void tile_of(int L, Unit& u) {
        static_assert(nwg % NXCD == 0 && nM % WGM == 0, "order constants");
        const int q = nwg / NXCD, xcd = L % NXCD, off = L / NXCD, wgid = xcd * q + off;
        const int nig = WGM * nN, gid = wgid / nig, fm = gid * WGM;
        u.pm = fm + ((wgid % nig) % WGM); u.pn = (wgid % nig) / WGM; }
    __host__ __device__ bool next(int i, Unit& u) const {
        const int L = i * G + c; if (L >= nwg) return false;
        tile_of(L, u); u.kt0 = 0; u.nkt = nkt; u.split = -1; return true;
    }
    __device__ __forceinline__ void a_ready(const Unit&) const {}
    __device__ __forceinline__ void done(const Unit&) const {}
};
constexpr int NS = 4;
struct TailOrder256 : StaticOrderT<4> {
    __host__ __device__ bool next(int i, Unit& u) const {
        const bool has_tail = c < 32 * NS, tail_now = has_tail && i == 0, full_now = has_tail ? (i == 1) : (i == 0);
        if (!(tail_now || full_now)) return false;
        tile_of(tail_now ? 256 + c / NS : c, u);
        u.nkt = tail_now ? nkt / NS : nkt; u.split = tail_now ? c % NS : -1; u.kt0 = tail_now ? (c % NS) * (nkt / NS) : 0;
        return true;
    }
};
__device__ __forceinline__ unsigned cvt_pk_bf16(float lo, float hi) { unsigned r; asm volatile("v_cvt_pk_bf16_f32 %0, %1, %2" : "=v"(r) : "v"(lo), "v"(hi)); return r; }
typedef float f32x2 __attribute__((ext_vector_type(2)));
constexpr float NORM_EPS = 1e-6f;
constexpr size_t EPI_WS_XB = (size_t)26 << 20, EPI_WS_SS = (size_t)206 << 20, EPI_WS_PART = (size_t)218 << 20, EPI_WS_CNT = (size_t)250 << 20;
typedef float f32x2e __attribute__((ext_vector_type(2)));
__device__ __forceinline__ float gelu_tanh(float v) {
    const float z = v * (1.0f + 0.044715f * v * v) * (-1.5957691216f * 1.4426950409f);
    return v * __builtin_amdgcn_rcpf(1.0f + __builtin_amdgcn_exp2f(z));
}
__device__ __forceinline__ float sigm(float g) { return __builtin_amdgcn_rcpf(1.0f + __builtin_amdgcn_exp2f(g * -1.4426950409f)); }
__device__ __forceinline__ float row_rstd(const float* ss, int row, int fq) {
    const f32x4 sp = *(const f32x4*)(ss + (size_t)row * 16 + fq * 4); float sr = (sp[0] + sp[1]) + (sp[2] + sp[3]); sr += __shfl_xor(sr, 16); sr += __shfl_xor(sr, 32);
    return __builtin_amdgcn_rsqf(sr * (1.0f / 1024.0f) + NORM_EPS);
}
__device__ __forceinline__ void row_rstd8(const float* ss, int row0, int fq, float (&rs)[2][4]) {
    f32x4 sp[2][4];
#pragma unroll
    for (int ai = 0; ai < 2; ++ai)
#pragma unroll
        for (int m = 0; m < 4; ++m) sp[ai][m] = *(const f32x4*)(ss + (size_t)(row0 + ai * HALF + m * 16) * 16 + fq * 4);
    asm volatile("" ::: "memory");
#pragma unroll
    for (int ai = 0; ai < 2; ++ai)
#pragma unroll
        for (int m = 0; m < 4; ++m) { float sr = (sp[ai][m][0] + sp[ai][m][1]) + (sp[ai][m][2] + sp[ai][m][3]); sr += __shfl_xor(sr, 16); sr += __shfl_xor(sr, 32);
            rs[ai][m] = __builtin_amdgcn_rsqf(sr * (1.0f / 1024.0f) + NORM_EPS); }
}
template <int MODE> struct EpiAct {
    static constexpr bool PERM = true, AFTER_DRAIN = false;
    bf16_t* O; int ldc; const float* ss; float* vst;
    __device__ __forceinline__ void operator()(f32x4 (&acc)[2][2][4][2], const Unit& u, int wr, int wc, int fr_, int fq_, int wid, int lane_) const {
        int fr = fr_, fq = fq_, lane = lane_; asm volatile("" : "+v"(fr), "+v"(fq), "+v"(lane));
        const int row0 = u.pm * BM + wr * 64 + fr, col0 = u.pn * BM + wc * 32 + 8 * fq;
        const bool act = (MODE == 0) && (u.pn < 4); const bool st = (MODE == 0) && (u.pn == 2 || u.pn == 3);
        float rsv[2][4]; row_rstd8(ss, row0, fq, rsv);
#pragma unroll
        for (int ai = 0; ai < 2; ++ai)
#pragma unroll
            for (int m = 0; m < 4; ++m) { const int row = row0 + ai * HALF + m * 16; const float rs = rsv[ai][m];
                bf16_t* rowp = O + (size_t)row * ldc + col0; float s1 = 0.f, s2 = 0.f;
#pragma unroll
                for (int bj = 0; bj < 2; ++bj) { f32x4 v0 = acc[ai][bj][m][0] * rs, v1 = acc[ai][bj][m][1] * rs;
                    if (MODE == 0) { if (act) {
#pragma unroll
                        for (int e = 0; e < 4; ++e) { v0[e] = gelu_tanh(v0[e]); v1[e] = gelu_tanh(v1[e]); } }
                        if (st) { s1 += (v0[0] + v0[1]) + (v0[2] + v0[3]) + (v1[0] + v1[1]) + (v1[2] + v1[3]);
                                  s2 += (v0[0] * v0[0] + v0[1] * v0[1]) + (v0[2] * v0[2] + v0[3] * v0[3]) + (v1[0] * v1[0] + v1[1] * v1[1]) + (v1[2] * v1[2] + v1[3] * v1[3]); } }
                    if (MODE == 2) {
#pragma unroll
                        for (int e = 0; e < 4; ++e) { const float a = fmaxf(v0[e], 0.f), b = fmaxf(v1[e], 0.f); v0[e] = a * a; v1[e] = b * b; } }
                    u32x4 w; w.x = cvt_pk_bf16(v0[0], v0[1]); w.y = cvt_pk_bf16(v0[2], v0[3]); w.z = cvt_pk_bf16(v1[0], v1[1]); w.w = cvt_pk_bf16(v1[2], v1[3]);
                    *(u32x4*)(rowp + bj * HALF) = w; }
                if (MODE == 0) { if (st) { s1 += __shfl_xor(s1, 16); s1 += __shfl_xor(s1, 32); s2 += __shfl_xor(s2, 16); s2 += __shfl_xor(s2, 32);
                    if (fq == 0) *(f32x2e*)(vst + (size_t)row * 16 + ((u.pn - 2) * 4 + wc) * 2) = (f32x2e){s1, s2}; } } }
    }
};
struct EpiOdd {
    static constexpr bool PERM = true, AFTER_DRAIN = false;
    bf16_t* O; const float* ss;
    __device__ __forceinline__ void operator()(f32x4 (&acc)[2][2][4][2], const Unit& u, int wr, int wc, int fr_, int fq_, int wid, int lane_) const {
        int fr = fr_, fq = fq_, lane = lane_; asm volatile("" : "+v"(fr), "+v"(fq), "+v"(lane));
        const int row0 = u.pm * BM + wr * 64 + fr, cin = wc * 32 + 8 * fq;
        const int mode = u.pn < 4 ? 0 : (u.pn < 8 ? 1 : 2);
        const int cbase = mode == 0 ? 128 * u.pn : (mode == 1 ? 1024 + 128 * (u.pn - 4) : 512 + 256 * (u.pn - 8));
        float rsv[2][4]; row_rstd8(ss, row0, fq, rsv);
#pragma unroll
        for (int ai = 0; ai < 2; ++ai)
#pragma unroll
            for (int m = 0; m < 4; ++m) { const int row = row0 + ai * HALF + m * 16; const float rs = rsv[ai][m];
                bf16_t* rowp = O + (size_t)row * 1536 + cbase + cin;
                f32x4 a0 = acc[ai][0][m][0] * rs, a1 = acc[ai][0][m][1] * rs, b0 = acc[ai][1][m][0] * rs, b1 = acc[ai][1][m][1] * rs;
                if (mode == 2) {
                    u32x4 w; w.x = cvt_pk_bf16(a0[0], a0[1]); w.y = cvt_pk_bf16(a0[2], a0[3]); w.z = cvt_pk_bf16(a1[0], a1[1]); w.w = cvt_pk_bf16(a1[2], a1[3]); *(u32x4*)rowp = w;
                    u32x4 x; x.x = cvt_pk_bf16(b0[0], b0[1]); x.y = cvt_pk_bf16(b0[2], b0[3]); x.z = cvt_pk_bf16(b1[0], b1[1]); x.w = cvt_pk_bf16(b1[2], b1[3]); *(u32x4*)(rowp + HALF) = x;
                } else {
                    if (mode == 0) {
#pragma unroll
                        for (int e = 0; e < 4; ++e) { b0[e] = sigm(b0[e]); b1[e] = sigm(b1[e]); } }
                    a0 = a0 * b0; a1 = a1 * b1;
                    u32x4 w; w.x = cvt_pk_bf16(a0[0], a0[1]); w.y = cvt_pk_bf16(a0[2], a0[3]); w.z = cvt_pk_bf16(a1[0], a1[1]); w.w = cvt_pk_bf16(a1[2], a1[3]); *(u32x4*)rowp = w;
                } }
    }
};
__device__ __forceinline__ float bfl(unsigned w) { return __uint_as_float(w << 16); }
__device__ __forceinline__ float bfh(unsigned w) { return __uint_as_float(w & 0xffff0000u); }
__device__ __forceinline__ void res_load(int use, const float* src, const bf16_t* hp, const bf16_t* lp, f32x4& x0, f32x4& x1) {
    if (use == 0) { x0 = *(const f32x4*)src; x1 = *(const f32x4*)(src + 4); }
    else { const u32x4 h = *(const u32x4*)hp, l = *(const u32x4*)lp;
        x0 = (f32x4){bfl(h.x) + bfl(l.x), bfh(h.x) + bfh(l.x), bfl(h.y) + bfl(l.y), bfh(h.y) + bfh(l.y)};
        x1 = (f32x4){bfl(h.z) + bfl(l.z), bfh(h.z) + bfh(l.z), bfl(h.w) + bfl(l.w), bfh(h.w) + bfh(l.w)}; }
}
__device__ __forceinline__ void res_store(bf16_t* hp, bf16_t* lp, const f32x4 x0, const f32x4 x1) {
    u32x4 h; h.x = cvt_pk_bf16(x0[0], x0[1]); h.y = cvt_pk_bf16(x0[2], x0[3]); h.z = cvt_pk_bf16(x1[0], x1[1]); h.w = cvt_pk_bf16(x1[2], x1[3]);
    u32x4 l; l.x = cvt_pk_bf16(x0[0] - bfl(h.x), x0[1] - bfh(h.x)); l.y = cvt_pk_bf16(x0[2] - bfl(h.y), x0[3] - bfh(h.y)); l.z = cvt_pk_bf16(x1[0] - bfl(h.z), x1[1] - bfh(h.z)); l.w = cvt_pk_bf16(x1[2] - bfl(h.w), x1[3] - bfh(h.w));
    *(u32x4*)hp = h; *(u32x4*)lp = l;
}
struct EpiRes {
    static constexpr bool PERM = true, AFTER_DRAIN = false;
    float* X; unsigned char* wsb; int use;
#if PROBE_OUT2 || PROBE_FF2X2
    int dry;
#endif
    __device__ __forceinline__ void operator()(f32x4 (&acc)[2][2][4][2], const Unit& u, int wr, int wc, int fr_, int fq_, int wid, int lane_) const {
        int fr = fr_, fq = fq_, lane = lane_; asm volatile("" : "+v"(fr), "+v"(fq), "+v"(lane));
#if PROBE_OUT2 || PROBE_FF2X2
        if (dry) return;
#endif
        if (u.split >= 0) {
            typedef unsigned long long u64;
            const int s = u.split, tt = (int)blockIdx.x / NS; float* part = (float*)(wsb + EPI_WS_PART); unsigned* cnt = (unsigned*)(wsb + EPI_WS_CNT) + use * 256 + tt * 8 + wid;
            u64* P = (u64*)(part + (((size_t)tt * NS + s) * 8 + wid) * 8192) + lane * 2;
#pragma unroll
            for (int q = 0; q < 4; ++q)
#pragma unroll
                for (int mm = 0; mm < 2; ++mm)
#pragma unroll
                    for (int bj = 0; bj < 2; ++bj)
#pragma unroll
                        for (int n = 0; n < 2; ++n) { const f32x4 v = acc[q >> 1][bj][2 * (q & 1) + mm][n]; u64* p = P + (q * 8 + (mm * 2 + bj) * 2 + n) * 128;
                            __hip_atomic_store(p, ((u64)__float_as_uint(v[1]) << 32) | __float_as_uint(v[0]), __ATOMIC_RELAXED, __HIP_MEMORY_SCOPE_AGENT);
                            __hip_atomic_store(p + 1, ((u64)__float_as_uint(v[3]) << 32) | __float_as_uint(v[2]), __ATOMIC_RELAXED, __HIP_MEMORY_SCOPE_AGENT); }
            asm volatile("s_waitcnt vmcnt(0)" ::: "memory");
            if (lane == 0) (void)__hip_atomic_fetch_add(cnt, 1u, __ATOMIC_RELAXED, __HIP_MEMORY_SCOPE_AGENT);
            return;
        }
        const int row0 = u.pm * BM + wr * 64 + fr, col0 = u.pn * BM + wc * 32 + 8 * fq;
        bf16_t* XB = (bf16_t*)(wsb + EPI_WS_XB); float* ssout = (float*)(wsb + EPI_WS_SS) + (size_t)(use + 1) * (18432 * 16);
        const float* xsrc = X - (u.pm < 64 ? 0 : (size_t)16384 * 1024) * 0;
        if (use == 0) { typedef const float* const __attribute__((address_space(4)))* KP; const KP ka = (KP)__builtin_amdgcn_kernarg_segment_ptr(); xsrc = (u.pm < 64) ? ka[0] : ka[1] - (size_t)16384 * 1024; }
#pragma unroll
        for (int ai = 0; ai < 2; ++ai)
#pragma unroll
            for (int m = 0; m < 4; ++m) { const int row = row0 + ai * HALF + m * 16; float sq = 0.f;
                bf16_t* bp = XB + (size_t)row * 1024 + col0; bf16_t* lp = (bf16_t*)X + (size_t)row * 2048 + 1024 + col0;
                const float* sp_ = xsrc + (size_t)row * 1024 + col0;
#pragma unroll
                for (int bj = 0; bj < 2; ++bj) { f32x4 x0, x1; res_load(use, sp_ + bj * HALF, bp + bj * HALF, lp + bj * HALF, x0, x1);
                    x0 += acc[ai][bj][m][0]; x1 += acc[ai][bj][m][1];
                    sq += (x0[0] * x0[0] + x0[1] * x0[1]) + (x0[2] * x0[2] + x0[3] * x0[3]) + (x1[0] * x1[0] + x1[1] * x1[1]) + (x1[2] * x1[2] + x1[3] * x1[3]);
                    res_store(bp + bj * HALF, lp + bj * HALF, x0, x1); }
                sq += __shfl_xor(sq, 16); sq += __shfl_xor(sq, 32);
                if (fq == 0) ssout[(size_t)row * 16 + u.pn * 4 + wc] = sq;
                if (m == 3) asm volatile("" ::: "memory"); }
    }
};
__device__ __forceinline__ void tail_job(float* X, unsigned char* wsb, int use, int job, int lane) {
    typedef unsigned long long u64;
    const int tt = job >> 5, w = (job >> 2) & 7, s = job & 3, wr = w >> 2, wc = w & 3, fr = lane & 15, fq = lane >> 4;
    float* part = (float*)(wsb + EPI_WS_PART); unsigned* cnt = (unsigned*)(wsb + EPI_WS_CNT) + use * 256 + tt * 8 + w;
    { unsigned spins = 0;
      while ((unsigned)__builtin_amdgcn_readfirstlane((int)__hip_atomic_load(cnt, __ATOMIC_RELAXED, __HIP_MEMORY_SCOPE_AGENT)) < (unsigned)NS) { __builtin_amdgcn_s_sleep(2); if (++spins > (1u << 22)) break; } }
    f32x4 v[2][2][2];
#pragma unroll
    for (int mm = 0; mm < 2; ++mm)
#pragma unroll
        for (int bj = 0; bj < 2; ++bj)
#pragma unroll
            for (int n = 0; n < 2; ++n) { f32x4 sum = (f32x4){0.f, 0.f, 0.f, 0.f};
#pragma unroll
                for (int sp = 0; sp < NS; ++sp) { const u64* qp = (const u64*)(part + (((size_t)tt * NS + sp) * 8 + w) * 8192) + lane * 2 + (s * 8 + (mm * 2 + bj) * 2 + n) * 128;
                    const u64 lo = __hip_atomic_load(qp, __ATOMIC_RELAXED, __HIP_MEMORY_SCOPE_AGENT), hi = __hip_atomic_load(qp + 1, __ATOMIC_RELAXED, __HIP_MEMORY_SCOPE_AGENT);
                    sum += (f32x4){__uint_as_float((unsigned)lo), __uint_as_float((unsigned)(lo >> 32)), __uint_as_float((unsigned)hi), __uint_as_float((unsigned)(hi >> 32))}; }
                v[mm][bj][n] = sum; }
    Unit u; StaticOrderT<4>::tile_of(256 + tt, u);
    const int ai = s >> 1, row0 = u.pm * BM + ai * HALF + wr * 64 + fr, col0 = u.pn * BM + wc * 32 + 8 * fq;
    bf16_t* XB = (bf16_t*)(wsb + EPI_WS_XB); float* ssout = (float*)(wsb + EPI_WS_SS) + (size_t)(use + 1) * (18432 * 16);
    const float* xsrc = X;
    if (use == 0) { typedef const float* const __attribute__((address_space(4)))* KP; const KP ka = (KP)__builtin_amdgcn_kernarg_segment_ptr(); xsrc = (u.pm < 64) ? ka[0] : ka[1] - (size_t)16384 * 1024; }
#pragma unroll
    for (int mm = 0; mm < 2; ++mm) { const int row = row0 + (2 * (s & 1) + mm) * 16; float sq = 0.f;
        bf16_t* bp = XB + (size_t)row * 1024 + col0; bf16_t* lp = (bf16_t*)X + (size_t)row * 2048 + 1024 + col0; const float* sp_ = xsrc + (size_t)row * 1024 + col0;
#pragma unroll
        for (int bj = 0; bj < 2; ++bj) { f32x4 x0, x1; res_load(use, sp_ + bj * HALF, bp + bj * HALF, lp + bj * HALF, x0, x1);
            x0 += v[mm][bj][0]; x1 += v[mm][bj][1];
            sq += (x0[0] * x0[0] + x0[1] * x0[1]) + (x0[2] * x0[2] + x0[3] * x0[3]) + (x1[0] * x1[0] + x1[1] * x1[1]) + (x1[2] * x1[2] + x1[3] * x1[3]);
            res_store(bp + bj * HALF, lp + bj * HALF, x0, x1); }
        sq += __shfl_xor(sq, 16); sq += __shfl_xor(sq, 32);
        if (fq == 0) ssout[(size_t)row * 16 + u.pn * 4 + wc] = sq; }
}

template <class Epi, class Sched, bool ALIGN_EPI = false, bool SP2 = false>
__device__ __forceinline__ void gemm_phase(PG8_LAS unsigned char* lds, const Gemm g, const Sched& S, const Epi& E, const int tid_in) {
    const int tid = tid_in, wid = __builtin_amdgcn_readfirstlane(tid >> 6), lane = tid & 63, wr = wid >> 2, wc = wid & 3, fr = lane & 15, fq = lane >> 4;
    const int K = g.K;
    unsigned voffA[2], voffB[2];
#pragma unroll
    for (int i = 0; i < 2; ++i) { int R, C; stage_rc(tid * 16 + i * 8192, R, C); const int Rb = Epi::PERM ? ((R & ~31) + perm32(R & 31)) : R;
        voffA[i] = (unsigned)(R * K + C) * 2u; voffB[i] = (unsigned)(Rb * K + C) * 2u; }
    const size_t kstep = (size_t)(BK * 2);
    const size_t hstep = (size_t)HALF * K * 2;
    const size_t tstep = 2 * hstep;
    const unsigned ldsw = (unsigned)wid * 1024u;
    const int aoff = lds_byte(wr * 64 + fr, fq * 8), boff = lds_byte(wc * 32 + fr, fq * 8);
#define PG8_SA(b, h) (((b) * 2 + (h)) * HTB)
#define PG8_SB(b, h) ((4 + (b) * 2 + (h)) * HTB)
#define PG8_STAGE(bufoff, gbase, voff) do { _Pragma("unroll") for (int _i = 0; _i < 2; ++_i) \
        __builtin_amdgcn_global_load_lds((const unsigned*)((const char*)(gbase) + (voff)[_i]), (PG8_LAS unsigned*)(lds + (bufoff) + ldsw + _i * 8192), 16, 0, 0); } while (0)
#define PG8_LDA(dst, b, h) do { _Pragma("unroll") for (int m = 0; m < 4; ++m) _Pragma("unroll") for (int k = 0; k < 2; ++k) dst[m][k] = *(const PG8_LAS bf16x8*)(lds + PG8_SA(b, h) + aoff + m * 2048 + k * 1024); } while (0)
#define PG8_LDB(dst, b, h) do { _Pragma("unroll") for (int n = 0; n < 2; ++n) _Pragma("unroll") for (int k = 0; k < 2; ++k) dst[n][k] = *(const PG8_LAS bf16x8*)(lds + PG8_SB(b, h) + boff + n * 2048 + k * 1024); } while (0)
#define PG8_MMA(ai, bj, At, Bt) do { __builtin_amdgcn_s_setprio(1); _Pragma("unroll") for (int m = 0; m < 4; ++m) _Pragma("unroll") for (int n = 0; n < 2; ++n) _Pragma("unroll") for (int k = 0; k < 2; ++k) \
        acc[ai][bj][m][n] = __builtin_amdgcn_mfma_f32_16x16x32_bf16(Bt[n][k], At[m][k], acc[ai][bj][m][n], 0, 0, 0); __builtin_amdgcn_s_setprio(0); } while (0)
#define PG8_WAIT_V(n) asm volatile("s_waitcnt vmcnt(" #n ")" ::: "memory")
#define PG8_WAIT_L(n) asm volatile("s_waitcnt lgkmcnt(" #n ")" ::: "memory")
#define PG8_BAR __builtin_amdgcn_s_barrier()
#define PG8_SCHED __builtin_amdgcn_sched_barrier(0)
    Unit cur, nxt; int ui = 0;
    if (!S.next(0, cur)) return;
    f32x4 acc[2][2][4][2];
#pragma unroll
    for (int a = 0; a < 2; ++a)
#pragma unroll
        for (int b = 0; b < 2; ++b)
#pragma unroll
            for (int m = 0; m < 4; ++m)
#pragma unroll
                for (int n = 0; n < 2; ++n) acc[a][b][m][n] = (f32x4){0.f, 0.f, 0.f, 0.f};
    bf16x8 At[4][2], B0[2][2], B1[2][2];
    const char* cA = (const char*)g.A + (size_t)cur.pm * tstep + (size_t)cur.kt0 * kstep; const char* cB = (const char*)g.Bt + (size_t)cur.pn * tstep + (size_t)cur.kt0 * kstep;
    S.a_ready(cur);
    if constexpr (SP2) {
        PG8_STAGE(PG8_SB(0, 0), cB, voffB); PG8_STAGE(PG8_SB(0, 1), cB + hstep, voffB); PG8_STAGE(PG8_SA(0, 0), cA, voffA); PG8_STAGE(PG8_SA(0, 1), cA + hstep, voffA);
        if (wr == 1) PG8_BAR;
        PG8_WAIT_V(2); PG8_BAR;
        PG8_STAGE(PG8_SB(1, 0), cB + kstep, voffB); PG8_STAGE(PG8_SA(1, 0), cA + kstep, voffA); PG8_STAGE(PG8_SB(1, 1), cB + hstep + kstep, voffB);
        PG8_WAIT_V(6); PG8_BAR;
    } else {
        PG8_STAGE(PG8_SB(0, 0), cB, voffB); PG8_STAGE(PG8_SA(0, 0), cA, voffA); PG8_STAGE(PG8_SB(0, 1), cB + hstep, voffB); PG8_STAGE(PG8_SA(0, 1), cA + hstep, voffA);
        if (wr == 1) PG8_BAR;
        PG8_WAIT_V(4); PG8_BAR;
        PG8_STAGE(PG8_SB(1, 0), cB + kstep, voffB); PG8_STAGE(PG8_SA(1, 0), cA + kstep, voffA); PG8_STAGE(PG8_SB(1, 1), cB + hstep + kstep, voffB);
        PG8_WAIT_V(6); PG8_BAR;
    }
    for (;;) {
        const bool has_next = S.next(ui + 1, nxt);
        const char* nA = has_next ? (const char*)g.A + (size_t)nxt.pm * tstep + (size_t)nxt.kt0 * kstep : cA; const char* nB = has_next ? (const char*)g.Bt + (size_t)nxt.pn * tstep + (size_t)nxt.kt0 * kstep : cB;
        const int nt = cur.nkt;
        for (int t = 0; t < nt; t += 2) {
            const bool last = (t == nt - 2);
            const char* a1 = cA + (size_t)(t + 1) * kstep;
            const char* a2 = last ? nA : cA + (size_t)(t + 2) * kstep; const char* b2 = last ? nB : cB + (size_t)(t + 2) * kstep;
            const char* a3 = a2 + kstep; const char* b3 = b2 + kstep;
            if (last && has_next) S.a_ready(nxt);
            if constexpr (SP2) {
            PG8_LDB(B0, 0, 0); PG8_LDB(B1, 0, 1); PG8_SCHED; PG8_LDA(At, 0, 0); PG8_STAGE(PG8_SA(1, 1), a1 + hstep, voffA);
            PG8_WAIT_V(8); PG8_WAIT_L(0); PG8_BAR; PG8_MMA(0, 0, At, B0); PG8_MMA(0, 1, At, B1); PG8_BAR; PG8_SCHED;
            PG8_LDA(At, 0, 1); PG8_STAGE(PG8_SB(0, 0), b2, voffB); PG8_STAGE(PG8_SB(0, 1), b2 + hstep, voffB); PG8_STAGE(PG8_SA(0, 0), a2, voffA);
            PG8_WAIT_V(8); PG8_WAIT_L(0); PG8_BAR; PG8_MMA(1, 0, At, B0); PG8_MMA(1, 1, At, B1); PG8_BAR; PG8_SCHED;
            PG8_LDB(B0, 1, 0); PG8_LDB(B1, 1, 1); PG8_SCHED; PG8_LDA(At, 1, 0); PG8_STAGE(PG8_SA(0, 1), a2 + hstep, voffA);
            PG8_WAIT_V(8); PG8_WAIT_L(0); PG8_BAR; PG8_MMA(0, 0, At, B0); PG8_MMA(0, 1, At, B1); PG8_BAR; PG8_SCHED;
            PG8_LDA(At, 1, 1); PG8_STAGE(PG8_SB(1, 0), b3, voffB); PG8_STAGE(PG8_SB(1, 1), b3 + hstep, voffB); PG8_STAGE(PG8_SA(1, 0), a3, voffA);
            PG8_WAIT_V(8); PG8_WAIT_L(0); PG8_BAR; PG8_MMA(1, 0, At, B0); PG8_MMA(1, 1, At, B1); PG8_BAR; PG8_SCHED;
            } else {
            PG8_LDB(B0, 0, 0); PG8_SCHED; PG8_LDA(At, 0, 0); PG8_STAGE(PG8_SA(1, 1), a1 + hstep, voffA);
            PG8_WAIT_L(8); PG8_BAR; PG8_WAIT_L(0); PG8_MMA(0, 0, At, B0); PG8_BAR; PG8_SCHED;
            PG8_LDB(B1, 0, 1); PG8_STAGE(PG8_SB(0, 0), b2, voffB);
            PG8_BAR; PG8_WAIT_L(0); PG8_MMA(0, 1, At, B1); PG8_BAR;
            PG8_LDA(At, 0, 1); PG8_STAGE(PG8_SA(0, 0), a2, voffA);
            PG8_BAR; PG8_WAIT_L(0); PG8_MMA(1, 0, At, B0); PG8_BAR; PG8_SCHED;
            PG8_STAGE(PG8_SB(0, 1), b2 + hstep, voffB);
            PG8_WAIT_V(6); PG8_BAR; PG8_MMA(1, 1, At, B1); PG8_BAR;
            PG8_LDB(B0, 1, 0); PG8_SCHED; PG8_LDA(At, 1, 0); PG8_STAGE(PG8_SA(0, 1), a2 + hstep, voffA);
            PG8_WAIT_L(8); PG8_BAR; PG8_WAIT_L(0); PG8_MMA(0, 0, At, B0); PG8_BAR; PG8_SCHED;
            PG8_LDB(B1, 1, 1); PG8_STAGE(PG8_SB(1, 0), b3, voffB);
            PG8_BAR; PG8_WAIT_L(0); PG8_MMA(0, 1, At, B1); PG8_BAR;
            PG8_LDA(At, 1, 1); PG8_STAGE(PG8_SA(1, 0), a3, voffA);
            PG8_BAR; PG8_WAIT_L(0); PG8_MMA(1, 0, At, B0); PG8_BAR; PG8_SCHED;
            PG8_STAGE(PG8_SB(1, 1), b3 + hstep, voffB);
            PG8_WAIT_V(6); PG8_BAR; PG8_MMA(1, 1, At, B1); PG8_BAR;
            }
        }
        if constexpr (ALIGN_EPI) { if (wr == 0) PG8_BAR; }
        if constexpr (!Epi::AFTER_DRAIN) { E(acc, cur, wr, wc, fr, fq, wid, lane); S.done(cur); }
        if (!has_next) break;
#pragma unroll
        for (int a = 0; a < 2; ++a)
#pragma unroll
            for (int b = 0; b < 2; ++b)
#pragma unroll
                for (int m = 0; m < 4; ++m)
#pragma unroll
                    for (int n = 0; n < 2; ++n) acc[a][b][m][n] = (f32x4){0.f, 0.f, 0.f, 0.f};
        cur = nxt; cA = nA; cB = nB; ++ui;
        if constexpr (ALIGN_EPI) { if (wr == 1) PG8_BAR; }
    }
    PG8_WAIT_V(0);
    if constexpr (!ALIGN_EPI) { if (wr == 0) PG8_BAR; }
    PG8_BAR;
    if constexpr (Epi::AFTER_DRAIN) { E.fused(acc, cur, wr, wc, fr, fq, lds, wid, lane); S.done(cur); }
#undef PG8_SA
#undef PG8_SB
#undef PG8_STAGE
#undef PG8_LDA
#undef PG8_LDB
#undef PG8_MMA
#undef PG8_WAIT_V
#undef PG8_WAIT_L
#undef PG8_BAR
#undef PG8_SCHED
}
}

namespace cg = cooperative_groups;
#define GAS __attribute__((address_space(1)))
#define LAS __attribute__((address_space(3)))
typedef unsigned short bf16;
typedef unsigned v4u __attribute__((ext_vector_type(4)));
typedef unsigned v2u __attribute__((ext_vector_type(2)));
typedef float f32x4 __attribute__((ext_vector_type(4)));
typedef float f32x2 __attribute__((ext_vector_type(2)));
typedef short bf16x8 __attribute__((ext_vector_type(8)));

constexpr int NWAVES = 8, NTHR = 512;
constexpr int D = 1024, MP = 16384, MS = 2048, M = MP + MS, FF = 4096, EVEN_IN = 1536, ODD_IN = 2560, SEQ = 8192;
constexpr float EPS = 1e-6f;
constexpr int LDS_BYTES = 147456;
constexpr size_t MiB = 1u << 20;
constexpr size_t WS_SS = 206 * MiB;
constexpr size_t WS_WIN = 1 * MiB;
constexpr size_t WS_WOUT = 6 * MiB;
constexpr size_t WS_WFF1 = 10 * MiB;
constexpr size_t WS_WFF2 = 18 * MiB;
constexpr size_t WS_XB = 26 * MiB;
constexpr size_t WS_H = 62 * MiB;
constexpr size_t WS_Z = WS_H;
constexpr size_t WS_MIX = 152 * MiB;
constexpr size_t WS_PART = 218 * MiB;
constexpr size_t WS_CNT = 250 * MiB;
constexpr size_t CNT_BYTES = 8 * 256 * 4;
constexpr size_t WS_BAR = WS_CNT + CNT_BYTES;
constexpr size_t ZERO_BYTES = 24576;
constexpr size_t WS_VST = 251 * MiB;
constexpr size_t WS_END = 253 * MiB;
static_assert(pg8::NS == 4, "partial buffer sized for 4 slices");
static_assert(pg8::EPI_WS_XB == WS_XB && pg8::EPI_WS_SS == WS_SS && pg8::EPI_WS_PART == WS_PART && pg8::EPI_WS_CNT == WS_CNT, "epilogue view of the d_ws map");
constexpr size_t O_Y = 0, O_POOL_P = (size_t)M * D, O_CC_P = O_POOL_P + 2 * 2 * 15 * 512, O_CD_P = O_CC_P + 2 * 2 * 30 * 512, O_AV_S = O_CD_P + 2 * 2 * 2 * 512,
                 O_POOL_S = O_AV_S + (size_t)2 * 32 * 64 * 512, O_CC_S = O_POOL_S + 2 * 32 * 15 * 512, O_CD_S = O_CC_S + 2 * 32 * 30 * 512, O_END = O_CD_S + 2 * 32 * 2 * 512;
static_assert(O_END == 22607872, "output size");

__device__ __forceinline__ float wave_sum(float v) {
#pragma unroll
    for (int o = 1; o < 64; o <<= 1) v += __shfl_xor(v, o);
    return v;
}
__device__ __forceinline__ unsigned pk2(float lo, float hi) { return pg8::cvt_pk_bf16(lo, hi); }
__device__ __forceinline__ float bflo(unsigned w) { return __uint_as_float(w << 16); }
__device__ __forceinline__ float bfhi(unsigned w) { return __uint_as_float(w & 0xffff0000u); }
__device__ __forceinline__ void unpack8(const v4u w, f32x4& a, f32x4& b) { a = (f32x4){bflo(w.x), bfhi(w.x), bflo(w.y), bfhi(w.y)}; b = (f32x4){bflo(w.z), bfhi(w.z), bflo(w.w), bfhi(w.w)}; }
__device__ __forceinline__ v4u pack8(const f32x4 a, const f32x4 b) { v4u w; w.x = pk2(a[0], a[1]); w.y = pk2(a[2], a[3]); w.z = pk2(b[0], b[1]); w.w = pk2(b[2], b[3]); return w; }
__device__ __forceinline__ float sigmoidf_(float g) { return __builtin_amdgcn_rcpf(1.0f + __builtin_amdgcn_exp2f(g * -1.4426950409f)); }

__device__ __forceinline__ int odd_src_col(int n0) { const int p = n0 >> 8, hf = (n0 >> 7) & 1, j = n0 & 127; return p < 4 ? hf * 512 + 128 * p + j : (p < 8 ? 1536 + hf * 512 + 128 * (p - 4) + j : 1024 + (n0 - 2048)); }
__device__ __forceinline__ void cvt_item(const float* W, int K, int N, const float* gk, bf16* WT, LAS float* scr, int item, int lane, bool remap = false) {
    const int nblk = N / 32, kb = item / nblk, nb = item % nblk, k0 = 64 * kb, n0 = 32 * nb, s0 = remap ? odd_src_col(n0) : n0;
#pragma unroll 1
    for (int hb = 0; hb < 2; ++hb) {
        float wv[16]; const float* wp = W + (size_t)(k0 + 32 * hb + (lane >> 5)) * N + s0 + (lane & 31);
#pragma unroll
        for (int i = 0; i < 16; ++i) wv[i] = wp[(size_t)(2 * i) * N];
#pragma unroll
        for (int i = 0; i < 16; ++i) { const int kk = 32 * hb + 2 * i + (lane >> 5); float w = wv[i]; if (gk) w *= gk[k0 + kk]; scr[kk * 33 + (lane & 31)] = w; }
    }
    asm volatile("s_waitcnt lgkmcnt(0)" ::: "memory");
    const int c = lane & 7;
#pragma unroll
    for (int j = 0; j < 4; ++j) { const int n = (lane >> 3) + 8 * j; const LAS float* s = scr + (8 * c) * 33 + n;
        v4u o; o.x = pk2(s[0 * 33], s[1 * 33]); o.y = pk2(s[2 * 33], s[3 * 33]); o.z = pk2(s[4 * 33], s[5 * 33]); o.w = pk2(s[6 * 33], s[7 * 33]);
        *(v4u*)(WT + (size_t)(n0 + n) * K + k0 + 8 * c) = o; }
    asm volatile("s_waitcnt lgkmcnt(0)" ::: "memory");
}
__device__ __forceinline__ void fold_item(const float* Wo, const float* pw, const float* bs, bf16* WT, LAS float* scr, int item, int lane) {
    const int nb = item & 31, ch = (item >> 5) & 1, g = item >> 6, n0 = nb * 32, c = ch * 64 + lane;
    { const int n = lane & 31, dh = lane >> 5; const float* wp = Wo + (size_t)(512 + g * 128 + dh) * 1024 + n0 + n; const float* sp = bs + g * 128 + dh;
#pragma unroll 1
      for (int b = 0; b < 4; ++b) { float wv[16], sv[16];
#pragma unroll
          for (int i = 0; i < 16; ++i) { wv[i] = wp[(size_t)(2 * (b * 16 + i)) * 1024]; sv[i] = sp[2 * (b * 16 + i)]; }
#pragma unroll
          for (int i = 0; i < 16; ++i) scr[(2 * (b * 16 + i) + dh) * 32 + n] = wv[i] * sv[i]; } }
    asm volatile("s_waitcnt lgkmcnt(0)" ::: "memory");
    f32x4 acc[8];
#pragma unroll
    for (int i = 0; i < 8; ++i) acc[i] = (f32x4){0.f, 0.f, 0.f, 0.f};
    const float* pr = pw + ((size_t)g * 128 + c) * 128;
#pragma unroll 1
    for (int d0 = 0; d0 < 128; d0 += 32) { f32x4 pv[8];
#pragma unroll
        for (int j = 0; j < 8; ++j) pv[j] = *(const f32x4*)(pr + d0 + 4 * j);
#pragma unroll
        for (int j = 0; j < 8; ++j)
#pragma unroll
            for (int dd = 0; dd < 4; ++dd)
#pragma unroll
                for (int n4 = 0; n4 < 8; ++n4) { const f32x4 w = *(const LAS f32x4*)(scr + (d0 + 4 * j + dd) * 32 + n4 * 4); acc[n4] += w * pv[j][dd]; } }
#pragma unroll
    for (int n4 = 0; n4 < 8; ++n4)
#pragma unroll
        for (int e = 0; e < 4; ++e) WT[(size_t)(n0 + n4 * 4 + e) * 1024 + 512 + g * 128 + c] = (bf16)(pk2(acc[n4][e], 0.f) & 0xffffu);
    asm volatile("s_waitcnt lgkmcnt(0)" ::: "memory");
}

struct Args { const float* in[25]; float* out; unsigned char* ws; };
typedef const __attribute__((address_space(4))) Args* CArgs;
#define LAUNDER_V(x) asm volatile("" : "+v"(x))
#define LAUNDER_S(x) asm volatile("" : "+s"(x))

__device__ __forceinline__ int cvt_count(int kind, int layer) {
    if (kind == 0) return (layer & 1) ? 16 * (ODD_IN / 32) : 16 * (EVEN_IN / 32);
    if (kind == 1) return (layer & 1) ? 16 * 32 : 8 * 32 + 256;
    if (kind == 2) return 16 * (FF / 32);
    return (FF / 64) * 32;
}
__device__ __forceinline__ void cvt_do(CArgs A, int kind, int layer, int item, LAS float* scr, int lane) {
    unsigned char* ws = A->ws; const int i = layer >> 1;
    if (kind == 0) {
        if (layer & 1) cvt_item(A->in[16] + (size_t)i * D * ODD_IN, D, ODD_IN, A->in[5] + layer * D, (bf16*)(ws + WS_WIN), scr, item, lane, true);
        else cvt_item(A->in[8] + (size_t)i * D * EVEN_IN, D, EVEN_IN, A->in[5] + layer * D, (bf16*)(ws + WS_WIN), scr, item, lane);
    } else if (kind == 1) {
        bf16* wt = (bf16*)(ws + WS_WOUT + (size_t)(layer & 1) * 2 * MiB);
        if (layer & 1) cvt_item(A->in[17] + (size_t)i * D * D, D, D, nullptr, wt, scr, item, lane);
        else { if (item < 256) cvt_item(A->in[9] + (size_t)i * D * D, D, D, nullptr, wt, scr, item, lane);
               else fold_item(A->in[9] + (size_t)i * D * D, A->in[14] + (size_t)i * 4 * 128 * 128, A->in[15] + i * 512, wt, scr, item - 256, lane); }
    } else if (kind == 2) cvt_item(A->in[23] + (size_t)layer * D * FF, D, FF, A->in[6] + layer * D, (bf16*)(ws + WS_WFF1), scr, item, lane);
    else cvt_item(A->in[24] + (size_t)layer * FF * D, FF, D, nullptr, (bf16*)(ws + WS_WFF2), scr, item, lane);
}
__device__ __forceinline__ void cvt_run(CArgs A, int nk, int k0, int l0, int k1, int l1, int k2, int l2, int k3, int l3, LAS unsigned char* lds, int gw, int NGW, int wave, int lane) {
    LAS float* scr = (LAS float*)(lds + wave * 16384);
    const int c0 = cvt_count(k0, l0), c1 = nk > 1 ? cvt_count(k1, l1) : 0, c2 = nk > 2 ? cvt_count(k2, l2) : 0, c3 = nk > 3 ? cvt_count(k3, l3) : 0;
    const int tot = c0 + c1 + c2 + c3;
    for (int it = gw; it < tot; it += NGW) {
        int r = it;
        if (r < c0) { cvt_do(A, k0, l0, r, scr, lane); continue; } r -= c0;
        if (r < c1) { cvt_do(A, k1, l1, r, scr, lane); continue; } r -= c1;
        if (r < c2) { cvt_do(A, k2, l2, r, scr, lane); continue; } r -= c2;
        cvt_do(A, k3, l3, r, scr, lane);
    }
}

constexpr int VS_STRIDE = 66;
constexpr int ZE = 1536;
template <int WIN> __device__ __forceinline__ void pool_rows(const bf16* Z, bf16* MIX, const float* hist, float* pout, int rbase, int tfirst, int lr0, int colx, bool sample, bool lastchunk) {
    v4u x[WIN + 7];
#pragma unroll
    for (int k = 0; k < WIN + 7; ++k) { const int t = tfirst - WIN + 1 + k;
        if (t >= 0) x[k] = *(const v4u*)(Z + (size_t)(rbase + t) * ZE + 1024 + colx);
        else if (sample) { const float* hp = hist + (size_t)(15 + t) * 512; x[k] = pack8(*(const f32x4*)hp, *(const f32x4*)(hp + 4)); }
        else x[k] = (v4u){0u, 0u, 0u, 0u}; }
    f32x4 s0 = (f32x4){0.f, 0.f, 0.f, 0.f}, s1 = s0;
#pragma unroll
    for (int k = 0; k < WIN; ++k) { f32x4 a, b; unpack8(x[k], a, b); s0 += a; s1 += b; }
#pragma unroll
    for (int i = 0; i < 8; ++i) {
        const int t = tfirst + i; f32x4 xa, xb; unpack8(x[WIN - 1 + i], xa, xb);
        const int cnti = sample ? WIN : (t + 1 < WIN ? t + 1 : WIN);
        const float inv = 1.0f / (float)cnti;
        *(v4u*)(MIX + (size_t)(rbase + t) * D + 512 + colx) = pack8(s0 * inv - xa, s1 * inv - xb);
        if (lastchunk && lr0 + i >= 49) { float* po = pout + (size_t)(lr0 + i - 49) * 512; *(f32x4*)po = xa; *(f32x4*)(po + 4) = xb; }
        if (i < 7) { f32x4 na, nb, oa, ob; unpack8(x[WIN + i], na, nb); unpack8(x[i], oa, ob); s0 += na - oa; s1 += nb - ob; }
    }
}
__device__ __forceinline__ void even_unit(CArgs A, int ie, int q, LAS unsigned char* lds, int tid, int wave, int lane) {
    const bf16* Z = (const bf16*)(A->ws + WS_Z); bf16* MIX = (bf16*)(A->ws + WS_MIX); const float* VST = (const float*)(A->ws + WS_VST);
    const int row0 = q * 64; const bool sample = row0 >= MP;
    int t0, half, seq;
    if (!sample) { t0 = row0 & (SEQ - 1); half = (t0 >> 6) & 1; seq = row0 >> 13; } else { t0 = 0; half = 0; seq = (row0 - MP) >> 6; }
    const int nj = 64 * (half + 1), jrow0 = row0 - 64 * half, ioff = 64 * half;
    LAS f32x2* stat = (LAS f32x2*)(lds + 8 * 128 * VS_STRIDE * 2);
    LAS bf16* Vs = (LAS bf16*)lds + wave * 128 * VS_STRIDE;
    __syncthreads();
    if (tid < nj) {
        const float* vp = VST + (size_t)(jrow0 + tid) * 16;
        const f32x4 p0 = *(const f32x4*)vp, p1 = *(const f32x4*)(vp + 4), p2 = *(const f32x4*)(vp + 8), p3 = *(const f32x4*)(vp + 12);
        const float s = ((p0[0] + p0[2]) + (p1[0] + p1[2])) + ((p2[0] + p2[2]) + (p3[0] + p3[2])), qq = ((p0[1] + p0[3]) + (p1[1] + p1[3])) + ((p2[1] + p2[3]) + (p3[1] + p3[3]));
        const float mean = s * (1.0f / 512.0f), var = fmaxf(qq * (1.0f / 512.0f) - mean * mean, 0.f);
        stat[tid] = (f32x2){mean, __builtin_amdgcn_rsqf(var + EPS)};
    }
    __syncthreads();
    const int h = wave;
    {
        const int c8 = (lane & 7) * 8;
        const float* gp = A->in[12] + ie * 512 + h * 64 + c8; const float* bp = A->in[13] + ie * 512 + h * 64 + c8;
        const f32x4 g0 = *(const f32x4*)gp, g1 = *(const f32x4*)(gp + 4), b0 = *(const f32x4*)bp, b1 = *(const f32x4*)(bp + 4);
        for (int bb = 0; bb < nj / 64; ++bb) {
            v4u w[8];
#pragma unroll
            for (int i = 0; i < 8; ++i) w[i] = *(const v4u*)(Z + (size_t)(jrow0 + bb * 64 + i * 8 + (lane >> 3)) * ZE + 512 + h * 64 + c8);
#pragma unroll
            for (int i = 0; i < 8; ++i) {
                const int r = bb * 64 + i * 8 + (lane >> 3); f32x4 a, b; unpack8(w[i], a, b);
                const f32x2 st = stat[r];
                a = (a - st.x) * st.y * g0 + b0; b = (b - st.x) * st.y * g1 + b1;
                const v4u o = pack8(a, b);
                LAS unsigned* dst = (LAS unsigned*)(Vs + r * VS_STRIDE + c8);
                dst[0] = o.x; dst[1] = o.y; dst[2] = o.z; dst[3] = o.w;
                if (sample) { float* vo = A->out + O_AV_S + ((size_t)(ie * 32 + seq) * 64 + r) * 512 + h * 64 + c8; *(f32x4*)vo = a; *(f32x4*)(vo + 4) = b; }
            }
        }
    }
    asm volatile("s_waitcnt lgkmcnt(0)" ::: "memory");
    {
        const int fr = lane & 15, fq = lane >> 4;
        f32x4 acc[4][4];
#pragma unroll
        for (int a = 0; a < 4; ++a)
#pragma unroll
            for (int b = 0; b < 4; ++b) acc[a][b] = (f32x4){0.f, 0.f, 0.f, 0.f};
        const float* Wh = A->in[10] + ((size_t)(ie * 8 + h) * 128 + ioff) * 128 + (size_t)fr * 128 + 8 * fq;
        v2u uw[4][4]; float bias[4];
#pragma unroll
        for (int it = 0; it < 4; ++it) { bias[it] = A->in[11][(ie * 8 + h) * 128 + ioff + it * 16 + fr];
#pragma unroll
            for (int ct = 0; ct < 4; ++ct) uw[it][ct] = *(const v2u*)(Z + (size_t)(row0 + it * 16 + fr) * ZE + h * 64 + ct * 16 + 4 * fq); }
        f32x4 wn[4][2];
#pragma unroll
        for (int it = 0; it < 4; ++it) { wn[it][0] = *(const f32x4*)(Wh + it * 16 * 128); wn[it][1] = *(const f32x4*)(Wh + it * 16 * 128 + 4); }
        const int nks = nj / 32;
        for (int ks = 0; ks < nks; ++ks) {
            bf16x8 av[4], bv[4];
#pragma unroll
            for (int it = 0; it < 4; ++it) { const v4u pk = pack8(wn[it][0], wn[it][1]); bv[it] = __builtin_bit_cast(bf16x8, pk); }
            if (ks + 1 < nks) {
#pragma unroll
                for (int it = 0; it < 4; ++it) { wn[it][0] = *(const f32x4*)(Wh + it * 16 * 128 + (ks + 1) * 32); wn[it][1] = *(const f32x4*)(Wh + it * 16 * 128 + (ks + 1) * 32 + 4); } }
#pragma unroll
            for (int ct = 0; ct < 4; ++ct) {
                const LAS bf16* p = Vs + (ks * 32 + 8 * fq) * VS_STRIDE + ct * 16 + fr;
#pragma unroll
                for (int e = 0; e < 8; ++e) av[ct][e] = (short)p[e * VS_STRIDE];
            }
#pragma unroll
            for (int ct = 0; ct < 4; ++ct)
#pragma unroll
                for (int it = 0; it < 4; ++it) acc[ct][it] = __builtin_amdgcn_mfma_f32_16x16x32_bf16(av[ct], bv[it], acc[ct][it], 0, 0, 0);
        }
#pragma unroll
        for (int it = 0; it < 4; ++it) {
            const int row = row0 + it * 16 + fr;
#pragma unroll
            for (int ct = 0; ct < 4; ++ct) {
                const int col = h * 64 + ct * 16 + 4 * fq;
                const f32x4 uu = (f32x4){bflo(uw[it][ct].x), bfhi(uw[it][ct].x), bflo(uw[it][ct].y), bfhi(uw[it][ct].y)};
                const f32x4 y = uu * (acc[ct][it] + bias[it]);
                v2u o; o.x = pk2(y[0], y[1]); o.y = pk2(y[2], y[3]);
                *(v2u*)(MIX + (size_t)row * D + col) = o;
            }
        }
    }
    {
        const int g = wave & 3, rh = wave >> 2, cb = lane & 15, rs = lane >> 4;
        const int colx = g * 128 + cb * 8;
        const int rbase = row0 - t0;
        const bool lastchunk = sample || (t0 == SEQ - 64);
        const float* hist = A->in[2] + ((size_t)(ie * 32 + seq) * 15) * 512 + colx;
        float* pout = sample ? (A->out + O_POOL_S + ((size_t)(ie * 32 + seq) * 15) * 512 + colx) : (A->out + O_POOL_P + ((size_t)(ie * 2 + seq) * 15) * 512 + colx);
        const int lr0 = 32 * rh + 8 * rs, tfirst = t0 + lr0;
        if (g == 0) pool_rows<2>(Z, MIX, hist, pout, rbase, tfirst, lr0, colx, sample, lastchunk);
        else if (g == 1) pool_rows<4>(Z, MIX, hist, pout, rbase, tfirst, lr0, colx, sample, lastchunk);
        else if (g == 2) pool_rows<8>(Z, MIX, hist, pout, rbase, tfirst, lr0, colx, sample, lastchunk);
        else pool_rows<16>(Z, MIX, hist, pout, rbase, tfirst, lr0, colx, sample, lastchunk);
    }
}

__device__ __forceinline__ void odd_unit(CArgs A, int io, int q, LAS unsigned char* lds, int tid, int wave, int lane) {
    const bf16* Z = (const bf16*)(A->ws + WS_Z); bf16* MIX = (bf16*)(A->ws + WS_MIX);
    const int row0 = q * 64; const bool sample = row0 >= MP;
    int t0, seq;
    if (!sample) { t0 = row0 & (SEQ - 1); seq = row0 >> 13; } else { t0 = 0; seq = (row0 - MP) >> 6; }
    const int rbase = row0 - t0; const int T = sample ? 64 : SEQ; const bool lastchunk = sample || (t0 == SEQ - 64);
    LAS bf16* cin = (LAS bf16*)lds;
    LAS float* cbuf = (LAS float*)(lds + 94 * 1024);
    {
        const int cb = tid & 63, rg = tid >> 6, ch = cb * 8;
        const float* dw = A->in[22] + (size_t)io * 3 * 512 + ch;
        const f32x4 w0a = *(const f32x4*)dw, w0b = *(const f32x4*)(dw + 4), w1a = *(const f32x4*)(dw + 512), w1b = *(const f32x4*)(dw + 516), w2a = *(const f32x4*)(dw + 1024), w2b = *(const f32x4*)(dw + 1028);
        const float* hd = A->in[4] + ((size_t)(io * 32 + seq) * 2) * 512 + ch;
        float* dout = sample ? (A->out + O_CD_S + ((size_t)(io * 32 + seq) * 2) * 512 + ch) : (A->out + O_CD_P + ((size_t)(io * 2 + seq) * 2) * 512 + ch);
        const int tf = t0 + 8 * rg;
        v4u dgw[10], gbw[8];
#pragma unroll
        for (int k = 0; k < 10; ++k) { const int t = tf - 2 + k;
            if (t >= 0) dgw[k] = *(const v4u*)(Z + (size_t)(rbase + t) * ZE + 1024 + ch);
            else if (sample) { const float* hp = hd + (size_t)(2 + t) * 512; dgw[k] = pack8(*(const f32x4*)hp, *(const f32x4*)(hp + 4)); }
            else dgw[k] = (v4u){0u, 0u, 0u, 0u}; }
#pragma unroll
        for (int i = 0; i < 8; ++i) gbw[i] = *(const v4u*)(Z + (size_t)(rbase + tf + i) * ZE + 512 + ch);
        f32x4 m2a, m2b, m1a, m1b; unpack8(dgw[0], m2a, m2b); unpack8(dgw[1], m1a, m1b);
#pragma unroll
        for (int i = 0; i < 8; ++i) {
            const int t = tf + i; f32x4 da, db, ga, gb; unpack8(dgw[2 + i], da, db); unpack8(gbw[i], ga, gb);
            const f32x4 ya = ga * (w0a * m2a + w1a * m1a + w2a * da), yb = gb * (w0b * m2b + w1b * m1b + w2b * db);
            *(v4u*)(MIX + (size_t)(rbase + t) * D + 512 + ch) = pack8(ya, yb);
            const int lr = 8 * rg + i;
            if (lastchunk && lr >= 62) { float* po = dout + (size_t)(lr - 62) * 512; *(f32x4*)po = da; *(f32x4*)(po + 4) = db; }
            m2a = m1a; m2b = m1b; m1a = da; m1b = db;
        }
    }
    __syncthreads();
    {
        const float* hc = A->in[3] + ((size_t)(io * 32 + seq) * 30) * 512;
        float* cout = sample ? (A->out + O_CC_S + ((size_t)(io * 32 + seq) * 30) * 512) : (A->out + O_CC_P + ((size_t)(io * 2 + seq) * 30) * 512);
        for (int base = tid; base < 94 * 64; base += 4 * NTHR) {
            v4u w[4];
#pragma unroll
            for (int u = 0; u < 4; ++u) { const int item = base + u * NTHR, lr = item >> 6, cb = item & 63, t = t0 + lr - 30;
                if (item < 94 * 64 && t >= 0) w[u] = *(const v4u*)(Z + (size_t)(rbase + t) * ZE + cb * 8);
                else if (item < 94 * 64 && sample) { const float* hp = hc + (size_t)(30 + t) * 512 + cb * 8; w[u] = pack8(*(const f32x4*)hp, *(const f32x4*)(hp + 4)); }
                else w[u] = (v4u){0u, 0u, 0u, 0u}; }
#pragma unroll
            for (int u = 0; u < 4; ++u) { const int item = base + u * NTHR, lr = item >> 6, cb = item & 63, t = t0 + lr - 30;
                if (item < 94 * 64) {
                    *(LAS v4u*)(cin + lr * 512 + cb * 8) = w[u];
                    if (lastchunk && lr >= 30 && t >= T - 30) { f32x4 a, b; unpack8(w[u], a, b); float* po = cout + (size_t)(t - (T - 30)) * 512 + cb * 8; *(f32x4*)po = a; *(f32x4*)(po + 4) = b; } } }
        }
    }
    __syncthreads();
    {
        const int cp = tid & 255, rq = tid >> 8;
        f32x2 w[31];
#pragma unroll
        for (int k = 0; k < 31; ++k) w[k] = *(const f32x2*)(A->in[18] + ((size_t)io * 31 + k) * 512 + 2 * cp);
        const f32x2 cbias = *(const f32x2*)(A->in[19] + io * 512 + 2 * cp);
        const float* lg = A->in[20] + io * 512 + lane * 8; const float* lb = A->in[21] + io * 512 + lane * 8;
        const f32x4 g0 = *(const f32x4*)lg, g1 = *(const f32x4*)(lg + 4), b0 = *(const f32x4*)lb, b1 = *(const f32x4*)(lb + 4);
        for (int sb = 0; sb < 4; ++sb) {
            const int r0 = 16 * sb + 8 * rq;
            f32x2 acc[8];
#pragma unroll
            for (int i = 0; i < 8; ++i) acc[i] = cbias;
#pragma unroll
            for (int j = 0; j < 38; ++j) { const unsigned xw = *(const LAS unsigned*)(cin + (r0 + j) * 512 + 2 * cp); const f32x2 x = (f32x2){bflo(xw), bfhi(xw)};
#pragma unroll
                for (int i = 0; i < 8; ++i) { if (j - i >= 0 && j - i < 31) acc[i] += w[j - i] * x; } }
#pragma unroll
            for (int i = 0; i < 8; ++i) *(LAS f32x2*)(cbuf + (8 * rq + i) * 512 + 2 * cp) = acc[i];
            __syncthreads();
#pragma unroll
            for (int rr = 0; rr < 2; ++rr) {
                const int lr = 2 * wave + rr;
                f32x4 a = *(const LAS f32x4*)(cbuf + lr * 512 + lane * 8), b = *(const LAS f32x4*)(cbuf + lr * 512 + lane * 8 + 4);
                const float s = wave_sum((a[0] + a[1]) + (a[2] + a[3]) + (b[0] + b[1]) + (b[2] + b[3]));
                const float mean = s * (1.0f / 512.0f);
                a = a - mean; b = b - mean;
                const float qq = wave_sum((a[0] * a[0] + a[1] * a[1]) + (a[2] * a[2] + a[3] * a[3]) + (b[0] * b[0] + b[1] * b[1]) + (b[2] * b[2] + b[3] * b[3]));
                const float rstd = __builtin_amdgcn_rsqf(qq * (1.0f / 512.0f) + EPS);
                a = a * rstd * g0 + b0; b = b * rstd * g1 + b1;
#pragma unroll
                for (int e = 0; e < 4; ++e) { a[e] = a[e] * sigmoidf_(a[e]); b[e] = b[e] * sigmoidf_(b[e]); }
                *(v4u*)(MIX + (size_t)(row0 + 16 * sb + lr) * D + lane * 8) = pack8(a, b);
            }
            __syncthreads();
        }
    }
}

#define RLX_AGENT __ATOMIC_RELAXED, __HIP_MEMORY_SCOPE_AGENT
#define XB_TMO      128
#define XB_XCNT(j)  (256  + 64 * (j))
#define XB_XSUB(j)  (1280 + 64 * (j))
#define XB_XGEN(j)  (2304 + 64 * (j))
#define XB_TOP      3328
#define XB_TOPGEN   3392
#define XCD_BAR_WORDS 3456
#define XB_SPIN_CAP (1u << 18)

__device__ __forceinline__ unsigned xb_ld(unsigned* p)              { return __hip_atomic_load(p, __ATOMIC_RELAXED, __HIP_MEMORY_SCOPE_AGENT); }
__device__ __forceinline__ unsigned xb_add(unsigned* p, unsigned v) { return __hip_atomic_fetch_add(p, v, __ATOMIC_RELAXED, __HIP_MEMORY_SCOPE_AGENT); }
__device__ __forceinline__ unsigned xb_xcc_id() { return (unsigned)__builtin_amdgcn_s_getreg((3 << 11) | 20) & 0xFu; }
#define XB_SPIN(cond, bar) do { unsigned _sp = 0; while (cond) { __builtin_amdgcn_s_sleep(1); \
    if ((++_sp & 255u) == 0u) { if (xb_ld(&(bar)[XB_TMO])) break; if (_sp > XB_SPIN_CAP) { atomicAdd(&(bar)[XB_TMO], 1u); break; } } } } while (0)

struct XcdBarrier {
    unsigned* bar; unsigned x;
    volatile LAS unsigned* st;
};

__device__ __forceinline__ XcdBarrier xcd_barrier_post(unsigned* bar, volatile LAS unsigned* st) {
    XcdBarrier b; b.bar = bar; b.x = xb_xcc_id(); b.st = st;
    if (threadIdx.x == 0) (void)xb_add(&bar[XB_XCNT(b.x)], 1u);
    return b;
}
__device__ __forceinline__ void xcd_barrier_complete(unsigned* bar, unsigned x, unsigned& nloc, unsigned& nx) {
    const unsigned G = gridDim.x * gridDim.y * gridDim.z;
    unsigned sum, cnt, mine, sp = 0u;
    for (;;) {
        sum = 0u; cnt = 0u; mine = 0u;
#pragma unroll
        for (unsigned j = 0; j < 16; ++j) { const unsigned c = xb_ld(&bar[XB_XCNT(j)]); sum += c; cnt += (c > 0u) ? 1u : 0u; mine = (j == x) ? c : mine; }
        if (sum == G) break;
        __builtin_amdgcn_s_sleep(1);
        if ((++sp & 255u) == 0u) { if (xb_ld(&bar[XB_TMO])) break; if (sp > XB_SPIN_CAP) { atomicAdd(&bar[XB_TMO], 1u); break; } }
    }
    nloc = mine > 0u ? mine : 1u; nx = cnt > 0u ? cnt : 1u;
}

__device__ __forceinline__ void xcd_barrier(const XcdBarrier& b) {
    asm volatile("s_waitcnt vmcnt(0)" ::: "memory");
    __syncthreads();
    if (threadIdx.x == 0) {
        unsigned* bar = b.bar;
        __builtin_amdgcn_s_waitcnt(0);
        unsigned nloc = b.st[0], nx = b.st[1];
        if (nloc == 0u) { xcd_barrier_complete(bar, b.x, nloc, nx); b.st[0] = nloc; b.st[1] = nx; }
        const unsigned old = xb_add(&bar[XB_XSUB(b.x)], 1u);
        const unsigned gen = old / nloc;
        if (old + 1u == (gen + 1u) * nloc) {
            __builtin_amdgcn_fence(__ATOMIC_RELEASE, "agent");
            asm volatile("s_waitcnt vmcnt(0)" ::: "memory");
            const unsigned og = xb_add(&bar[XB_TOP], 1u);
            const unsigned tg = og / nx;
            if (og + 1u == (tg + 1u) * nx) xb_add(&bar[XB_TOPGEN], 1u);
            else XB_SPIN(xb_ld(&bar[XB_TOPGEN]) == tg, bar);
            __builtin_amdgcn_fence(__ATOMIC_ACQUIRE, "agent");
            xb_add(&bar[XB_XGEN(b.x)], 1u);
            asm volatile("s_waitcnt vmcnt(0)" ::: "memory");
        } else {
            XB_SPIN(xb_ld(&bar[XB_XGEN(b.x)]) == gen, bar);
            __builtin_amdgcn_fence(__ATOMIC_ACQUIRE, "agent");
            asm volatile("s_waitcnt vmcnt(0)" ::: "memory");
        }
    }
    __syncthreads();
}

__global__ void __launch_bounds__(NTHR, 2) fwd_megakernel(Args A_unused) {
    extern __shared__ __attribute__((aligned(16))) unsigned char lds_raw[];
    LAS unsigned char* lds = (LAS unsigned char*)lds_raw;
    cg::grid_group grid = cg::this_grid();
    const CArgs A0 = (CArgs)__builtin_amdgcn_kernarg_segment_ptr();
    const int G = gridDim.x, bx = blockIdx.x;
    volatile LAS unsigned* xst = (volatile LAS unsigned*)(lds + LDS_BYTES - 64);
    if (threadIdx.x < 2) xst[threadIdx.x] = 0u;
    __syncthreads();
    const XcdBarrier xbar = xcd_barrier_post((unsigned*)(A0->ws + WS_BAR), xst);
#define GRID_SYNC1() xcd_barrier(xbar)
#define GRID_SYNC_CG() do { asm volatile("s_waitcnt vmcnt(0) lgkmcnt(0)" ::: "memory"); grid.sync(); } while (0)
#if PROBE_SYNC2
#define GRID_SYNC() do { GRID_SYNC1(); GRID_SYNC1(); } while (0)
#else
#define GRID_SYNC() GRID_SYNC1()
#endif
#define GRID_SYNC_UNUSED() do { } while (0)
#define PHASE_BEGIN() CArgs A = A0; LAUNDER_S(A); int tid = threadIdx.x; LAUNDER_V(tid); const int lane = tid & 63, wave = __builtin_amdgcn_readfirstlane(tid >> 6); const int gw = bx * NWAVES + wave, NGW = G * NWAVES; \
    unsigned char* ws = A->ws; float* X = A->out + O_Y; float* SS = (float*)(ws + WS_SS); bf16* XB = (bf16*)(ws + WS_XB); (void)lane; (void)gw; (void)NGW; (void)X; (void)SS; (void)XB

    {
        PHASE_BEGIN();
        cvt_run(A, 2, 0, 0, 1, 0, 0, 0, 0, 0, lds, gw, NGW, wave, lane);
        for (int m0 = gw; m0 < M; m0 += 3 * NGW) {
            f32x4 v[3][4];
#pragma unroll
            for (int r = 0; r < 3; ++r) { const int m = m0 + r * NGW; if (m < M) { const float* src = (m < MP) ? (A->in[0] + (size_t)m * D) : (A->in[1] + (size_t)(m - MP) * D);
#pragma unroll
                for (int j = 0; j < 4; ++j) v[r][j] = *(const f32x4*)(src + (lane + 64 * j) * 4); } }
#pragma unroll
            for (int r = 0; r < 3; ++r) { const int m = m0 + r * NGW; if (m < M) { float s2 = 0.f;
#pragma unroll
                for (int j = 0; j < 4; ++j) { s2 += (v[r][j][0] * v[r][j][0] + v[r][j][1] * v[r][j][1]) + (v[r][j][2] * v[r][j][2] + v[r][j][3] * v[r][j][3]);
                    v2u o; o.x = pk2(v[r][j][0], v[r][j][1]); o.y = pk2(v[r][j][2], v[r][j][3]); *(v2u*)(XB + (size_t)m * D + (lane + 64 * j) * 4) = o; }
                s2 = wave_sum(s2);
                if (lane < 4) *(f32x4*)(SS + (size_t)m * 16 + lane * 4) = (f32x4){lane == 0 ? s2 : 0.f, 0.f, 0.f, 0.f}; } }
        }
    }
    GRID_SYNC_CG();

#pragma unroll 1
    for (int layer = 0; layer < 4; ++layer) {
        const int i2 = layer >> 1; const bool odd = layer & 1;
#pragma unroll 1
        for (int rep = 0; rep < 1 + PROBE_IN2; ++rep) {
        if (!odd) { PHASE_BEGIN(); pg8::Gemm g{XB, (const bf16*)(ws + WS_WIN), M, EVEN_IN, D}; pg8::StaticOrderT<6> S; S.init(D, G, bx);
            pg8::EpiAct<0> E{(bf16*)(ws + WS_Z), EVEN_IN, SS + (size_t)(2 * layer) * M * 16, (float*)(ws + WS_VST)};
            pg8::gemm_phase<pg8::EpiAct<0>, pg8::StaticOrderT<6>, true, true>(lds, g, S, E, tid); }
        else { PHASE_BEGIN(); pg8::Gemm g{XB, (const bf16*)(ws + WS_WIN), M, ODD_IN, D}; pg8::StaticOrderT<10> S; S.init(D, G, bx);
            pg8::EpiOdd E{(bf16*)(ws + WS_Z), SS + (size_t)(2 * layer) * M * 16};
            pg8::gemm_phase<pg8::EpiOdd, pg8::StaticOrderT<10>, true, true>(lds, g, S, E, tid); } }
        GRID_SYNC();
#pragma unroll 1
        for (int rep = 0; rep < 1 + PROBE_MIX2; ++rep) {
        if (!odd) { PHASE_BEGIN(); for (int q = bx; q < M / 64; q += G) even_unit(A, i2, q, lds, tid, wave, lane); }
        else { PHASE_BEGIN(); for (int q = bx; q < M / 64; q += G) odd_unit(A, i2, q, lds, tid, wave, lane); }
        __syncthreads(); }
#pragma unroll 1
        for (int rep = 0; rep < 1 + PROBE_CVT2; ++rep)
        { PHASE_BEGIN();
          const bool skew = (G == 256); const int cgw = skew ? gw - 32 * NWAVES : gw, cng = skew ? NGW - 32 * NWAVES : NGW;
          if (cgw >= 0 && layer == 0) cvt_run(A, 1, 2, 0, 0, 0, 0, 0, 0, 0, lds, cgw, cng, wave, lane); }
        GRID_SYNC();
#pragma unroll 1
        for (int rep = 0; rep < 1 + PROBE_OUT2; ++rep)
        { PHASE_BEGIN(); pg8::Gemm g{(const bf16*)(ws + WS_MIX), (const bf16*)(ws + WS_WOUT + (size_t)(layer & 1) * 2 * MiB), M, D, D}; pg8::EpiRes E{X, ws, 2 * layer};
#if PROBE_OUT2 || PROBE_FF2X2
          E.dry = rep < PROBE_OUT2;
#endif

          if (G == 256) { pg8::TailOrder256 S; S.init(D, G, bx); pg8::gemm_phase<pg8::EpiRes, pg8::TailOrder256, true, true>(lds, g, S, E, tid); }
          else { pg8::StaticOrderT<4> S; S.init(D, G, bx); pg8::gemm_phase<pg8::EpiRes, pg8::StaticOrderT<4>, true, true>(lds, g, S, E, tid); } }
        { PHASE_BEGIN();
          if (G == 256 && bx >= 128) pg8::tail_job(X, ws, 2 * layer, (bx - 128) * NWAVES + wave, lane);
          const bool skew = (G == 256); const int cgw = skew ? gw - 128 * NWAVES : gw, cng = skew ? NGW - 128 * NWAVES : NGW;
          if (cgw >= 0) { if (layer < 3) cvt_run(A, 2, 3, layer, 0, layer + 1, 0, 0, 0, 0, lds, cgw, cng, wave, lane); else cvt_run(A, 1, 3, layer, 0, 0, 0, 0, 0, 0, lds, cgw, cng, wave, lane); } }
        GRID_SYNC();
#pragma unroll 1
        for (int rep = 0; rep < 1 + PROBE_FF1X2; ++rep)
        { PHASE_BEGIN(); pg8::Gemm g{XB, (const bf16*)(ws + WS_WFF1), M, FF, D}; pg8::StaticOrderT<16> S; S.init(D, G, bx);
          pg8::EpiAct<2> E{(bf16*)(ws + WS_H), FF, SS + (size_t)(2 * layer + 1) * M * 16, nullptr};
          pg8::gemm_phase<pg8::EpiAct<2>, pg8::StaticOrderT<16>, true, true>(lds, g, S, E, tid); }
        GRID_SYNC();
#pragma unroll 1
        for (int rep = 0; rep < 1 + PROBE_FF2X2; ++rep)
        { PHASE_BEGIN(); pg8::Gemm g{(const bf16*)(ws + WS_H), (const bf16*)(ws + WS_WFF2), M, D, FF}; pg8::EpiRes E{X, ws, 2 * layer + 1};
#if PROBE_OUT2 || PROBE_FF2X2
          E.dry = rep < PROBE_FF2X2;
#endif

          if (G == 256) { pg8::TailOrder256 S; S.init(FF, G, bx); pg8::gemm_phase<pg8::EpiRes, pg8::TailOrder256, true, true>(lds, g, S, E, tid); }
          else { pg8::StaticOrderT<4> S; S.init(FF, G, bx); pg8::gemm_phase<pg8::EpiRes, pg8::StaticOrderT<4>, true, true>(lds, g, S, E, tid); } }
        { PHASE_BEGIN(); if (G == 256 && bx >= 128) pg8::tail_job(X, ws, 2 * layer + 1, (bx - 128) * NWAVES + wave, lane); }
        if (layer < 3) { PHASE_BEGIN();
          const bool skew = (G == 256); const int cgw = skew ? gw - 128 * NWAVES : gw, cng = skew ? NGW - 128 * NWAVES : NGW;
          if (cgw >= 0) cvt_run(A, 2, 1, layer + 1, 2, layer + 1, 0, 0, 0, 0, lds, cgw, cng, wave, lane); }
        GRID_SYNC();
    }
    {
        PHASE_BEGIN();
        const float* fg = A->in[7]; const float* ss = SS + (size_t)8 * M * 16;
        f32x4 gv[4];
#pragma unroll
        for (int j = 0; j < 4; ++j) gv[j] = *(const f32x4*)(fg + (lane + 64 * j) * 4);
        const bf16* XL = (const bf16*)X;
        for (int m = gw; m < M; m += NGW) {
            const float spv = lane < 16 ? ss[(size_t)m * 16 + lane] : 0.f;
            v2u h[4], l[4];
#pragma unroll
            for (int j = 0; j < 4; ++j) { h[j] = *(const v2u*)(XB + (size_t)m * D + (lane + 64 * j) * 4); l[j] = *(const v2u*)(XL + (size_t)m * 2048 + 1024 + (lane + 64 * j) * 4); }
            const float rs = __builtin_amdgcn_rsqf(wave_sum(spv) * (1.0f / 1024.0f) + EPS);
            asm volatile("s_waitcnt vmcnt(0)" ::: "memory");
#pragma unroll
            for (int j = 0; j < 4; ++j) { const f32x4 x = (f32x4){bflo(h[j].x) + bflo(l[j].x), bfhi(h[j].x) + bfhi(l[j].x), bflo(h[j].y) + bflo(l[j].y), bfhi(h[j].y) + bfhi(l[j].y)};
                *(f32x4*)(X + (size_t)m * D + (lane + 64 * j) * 4) = x * rs * gv[j]; }
        }
    }
}

extern "C" void kernel_launch(void* const* d_in, const int* in_sizes, int n_in, void* d_out, int out_size, void* d_ws, size_t ws_size, hipStream_t stream) {
    static int grid = 0;
    if (grid == 0) {
        if (n_in != 25 || (size_t)out_size != O_END || ws_size < WS_END) { fprintf(stderr, "kernel_launch: unexpected shapes (n_in %d out %d ws %zu)\n", n_in, out_size, ws_size); grid = -1; return; }
        int dev = 0, cus = 0, per_cu = 0;
        (void)hipGetDevice(&dev); (void)hipDeviceGetAttribute(&cus, hipDeviceAttributeMultiprocessorCount, dev);
        (void)hipFuncSetAttribute((const void*)fwd_megakernel, hipFuncAttributeMaxDynamicSharedMemorySize, LDS_BYTES);
        (void)hipOccupancyMaxActiveBlocksPerMultiprocessor(&per_cu, (const void*)fwd_megakernel, NTHR, LDS_BYTES);
        (void)hipGetLastError();
        if (per_cu < 1) per_cu = 1;
        grid = cus * per_cu;
        fprintf(stderr, "kernel_launch: cus %d per_cu %d grid %d ws %zu\n", cus, per_cu, grid, ws_size);
    }
    if (grid < 0) return;
    (void)hipMemsetAsync((unsigned char*)d_ws + WS_CNT, 0, ZERO_BYTES, stream);
    Args a{};
    for (int i = 0; i < 25; ++i) a.in[i] = (const float*)d_in[i];
    a.out = (float*)d_out; a.ws = (unsigned char*)d_ws;
    void* args[] = {&a};
    hipError_t e = hipLaunchCooperativeKernel((const void*)fwd_megakernel, dim3(grid), dim3(NTHR), args, LDS_BYTES, stream);
    if (e != hipSuccess) fprintf(stderr, "cooperative launch failed: %s (grid %d)\n", hipGetErrorString(e), grid);
}
```

```cpp
#include <hip/hip_runtime.h>
#include <hip/hip_cooperative_groups.h>
#include <cstdio>
#include <cstdint>
#ifndef PROBE_SYNC2
#define PROBE_SYNC2 0
#define PROBE_MIX2 0
#define PROBE_CVT2 0
#define PROBE_FF1X2 0
#define PROBE_IN2 0
#define PROBE_OUT2 0
#define PROBE_FF2X2 0
#endif
namespace pg8 {
#define PG8_LAS __attribute__((address_space(3)))
typedef unsigned short bf16_t;
typedef short bf16x8 __attribute__((ext_vector_type(8)));
typedef float f32x4 __attribute__((ext_vector_type(4)));
typedef unsigned u32x4 __attribute__((ext_vector_type(4)));
constexpr int BM = 256, BK = 64, HALF = 128, HTB = HALF * BK * 2  , STAGE_BYTES = 8 * HTB, NXCD = 8, WGM = 8;

__host__ __device__ __forceinline__ int lds_byte(int r, int c) { const int st = (r >> 4) * 2 + (c >> 5), rr = r & 15, cc = c & 31, ob = rr * 64 + cc * 2; return st * 1024 + (ob ^ (((ob >> 9) & 1) << 5)); }
__host__ __device__ __forceinline__ void stage_rc(int b, int& R, int& C) { const int st = b / 1024, sb = b % 1024, swz = sb ^ (((sb >> 9) & 1) << 5); R = (st >> 1) * 16 + swz / 64; C = (st & 1) * 32 + (swz % 64) / 2; }
__host__ __device__ __forceinline__ int perm32(int rho) { const int n = rho >> 4, i = rho & 15; return 8 * (i >> 2) + 4 * n + (i & 3); }

struct Unit { int pm, pn, kt0, nkt, split; };
struct Gemm { const bf16_t* A; const bf16_t* Bt; int M, N, K; };

template <int NN> struct StaticOrderT {
    static constexpr int nM = 72, nN = NN, nwg = nM * nN, nkt_unused = 0;
    int G, c, nkt;
    __host__ __device__ void init(int K, int G_, int c_) { G = G_; c = c_; nkt = K / BK; }
    __host__ __device__ static void tile_of(int L, Unit& u) {
        static_assert(nwg % NXCD == 0 && nM % WGM == 0, "order constants");
        const int q = nwg / NXCD, xcd = L % NXCD, off = L / NXCD, wgid = xcd * q + off;
        const int nig = WGM * nN, gid = wgid / nig, fm = gid * WGM;
        u.pm = fm + ((wgid % nig) % WGM); u.pn = (wgid % nig) / WGM; }
    __host__ __device__ bool next(int i, Unit& u) const {
        const int L = i * G + c; if (L >= nwg) return false;
        tile_of(L, u); u.kt0 = 0; u.nkt = nkt; u.split = -1; return true;
    }
    __device__ __forceinline__ void a_ready(const Unit&) const {}
    __device__ __forceinline__ void done(const Unit&) const {}
};
constexpr int NS = 4;
struct TailOrder256 : StaticOrderT<4> {
    __host__ __device__ bool next(int i, Unit& u) const {
        const bool has_tail = c < 32 * NS, tail_now = has_tail && i == 0, full_now = has_tail ? (i == 1) : (i == 0);
        if (!(tail_now || full_now)) return false;
        tile_of(tail_now ? 256 + c / NS : c, u);
        u.nkt = tail_now ? nkt / NS : nkt; u.split = tail_now ? c % NS : -1; u.kt0 = tail_now ? (c % NS) * (nkt / NS) : 0;
        return true;
    }
};
template <class Base> struct Counted : Base {
    const unsigned* ready; unsigned need;
    __device__ __forceinline__ void a_ready(const Unit& u) const {
        if (threadIdx.x < 64) {
            unsigned spins = 0;
            while ((unsigned)__builtin_amdgcn_readfirstlane((int)__hip_atomic_load(ready + u.pm, __ATOMIC_RELAXED, __HIP_MEMORY_SCOPE_AGENT)) < need) { __builtin_amdgcn_s_sleep(2); if (++spins > (1u << 22)) break; }
            __builtin_amdgcn_fence(__ATOMIC_ACQUIRE, "agent");
            asm volatile("s_waitcnt vmcnt(0)" ::: "memory");
        }
        asm volatile("" ::: "memory"); __builtin_amdgcn_s_barrier(); asm volatile("" ::: "memory");
    }
};
__device__ __forceinline__ unsigned cvt_pk_bf16(float lo, float hi) { unsigned r; asm volatile("v_cvt_pk_bf16_f32 %0, %1, %2" : "=v"(r) : "v"(lo), "v"(hi)); return r; }
typedef float f32x2 __attribute__((ext_vector_type(2)));
constexpr float NORM_EPS = 1e-6f;
constexpr size_t EPI_WS_XB = (size_t)26 << 20, EPI_WS_SS = (size_t)206 << 20, EPI_WS_PART = (size_t)218 << 20, EPI_WS_CNT = (size_t)250 << 20;
typedef float f32x2e __attribute__((ext_vector_type(2)));
__device__ __forceinline__ float gelu_tanh(float v) {
    const float z = v * (1.0f + 0.044715f * v * v) * (-1.5957691216f * 1.4426950409f);
    return v * __builtin_amdgcn_rcpf(1.0f + __builtin_amdgcn_exp2f(z));
}
__device__ __forceinline__ float sigm(float g) { return __builtin_amdgcn_rcpf(1.0f + __builtin_amdgcn_exp2f(g * -1.4426950409f)); }
__device__ __forceinline__ float row_rstd(const float* ss, int row, int fq) {
    const f32x4 sp = *(const f32x4*)(ss + (size_t)row * 16 + fq * 4); float sr = (sp[0] + sp[1]) + (sp[2] + sp[3]); sr += __shfl_xor(sr, 16); sr += __shfl_xor(sr, 32);
    return __builtin_amdgcn_rsqf(sr * (1.0f / 1024.0f) + NORM_EPS);
}
__device__ __forceinline__ void row_rstd8(const float* ss, int row0, int fq, float (&rs)[2][4]) {
    f32x4 sp[2][4];
#pragma unroll
    for (int ai = 0; ai < 2; ++ai)
#pragma unroll
        for (int m = 0; m < 4; ++m) sp[ai][m] = *(const f32x4*)(ss + (size_t)(row0 + ai * HALF + m * 16) * 16 + fq * 4);
    asm volatile("" ::: "memory");
#pragma unroll
    for (int ai = 0; ai < 2; ++ai)
#pragma unroll
        for (int m = 0; m < 4; ++m) { float sr = (sp[ai][m][0] + sp[ai][m][1]) + (sp[ai][m][2] + sp[ai][m][3]); sr += __shfl_xor(sr, 16); sr += __shfl_xor(sr, 32);
            rs[ai][m] = __builtin_amdgcn_rsqf(sr * (1.0f / 1024.0f) + NORM_EPS); }
}
template <int MODE> struct EpiAct {
    static constexpr bool PERM = true, AFTER_DRAIN = false;
    bf16_t* O; int ldc; const float* ss; float* vst;
    __device__ __forceinline__ void operator()(f32x4 (&acc)[2][2][4][2], const Unit& u, int wr, int wc, int fr_, int fq_, int wid, int lane_) const {
        int fr = fr_, fq = fq_, lane = lane_; asm volatile("" : "+v"(fr), "+v"(fq), "+v"(lane));
        const int row0 = u.pm * BM + wr * 64 + fr, col0 = u.pn * BM + wc * 32 + 8 * fq;
        const bool act = (MODE == 0) && (u.pn < 4); const bool st = (MODE == 0) && (u.pn == 2 || u.pn == 3);
        float rsv[2][4]; row_rstd8(ss, row0, fq, rsv);
#pragma unroll
        for (int ai = 0; ai < 2; ++ai)
#pragma unroll
            for (int m = 0; m < 4; ++m) { const int row = row0 + ai * HALF + m * 16; const float rs = rsv[ai][m];
                bf16_t* rowp = O + (size_t)row * ldc + col0; float s1 = 0.f, s2 = 0.f;
#pragma unroll
                for (int bj = 0; bj < 2; ++bj) { f32x4 v0 = acc[ai][bj][m][0] * rs, v1 = acc[ai][bj][m][1] * rs;
                    if (MODE == 0) { if (act) {
#pragma unroll
                        for (int e = 0; e < 4; ++e) { v0[e] = gelu_tanh(v0[e]); v1[e] = gelu_tanh(v1[e]); } }
                        if (st) { s1 += (v0[0] + v0[1]) + (v0[2] + v0[3]) + (v1[0] + v1[1]) + (v1[2] + v1[3]);
                                  s2 += (v0[0] * v0[0] + v0[1] * v0[1]) + (v0[2] * v0[2] + v0[3] * v0[3]) + (v1[0] * v1[0] + v1[1] * v1[1]) + (v1[2] * v1[2] + v1[3] * v1[3]); } }
                    if (MODE == 2) {
#pragma unroll
                        for (int e = 0; e < 4; ++e) { const float a = fmaxf(v0[e], 0.f), b = fmaxf(v1[e], 0.f); v0[e] = a * a; v1[e] = b * b; } }
                    u32x4 w; w.x = cvt_pk_bf16(v0[0], v0[1]); w.y = cvt_pk_bf16(v0[2], v0[3]); w.z = cvt_pk_bf16(v1[0], v1[1]); w.w = cvt_pk_bf16(v1[2], v1[3]);
                    *(u32x4*)(rowp + bj * HALF) = w; }
                if (MODE == 0) { if (st) { s1 += __shfl_xor(s1, 16); s1 += __shfl_xor(s1, 32); s2 += __shfl_xor(s2, 16); s2 += __shfl_xor(s2, 32);
                    if (fq == 0) *(f32x2e*)(vst + (size_t)row * 16 + ((u.pn - 2) * 4 + wc) * 2) = (f32x2e){s1, s2}; } } }
    }
};
struct EpiOdd {
    static constexpr bool PERM = true, AFTER_DRAIN = false;
    bf16_t* O; const float* ss;
    __device__ __forceinline__ void operator()(f32x4 (&acc)[2][2][4][2], const Unit& u, int wr, int wc, int fr_, int fq_, int wid, int lane_) const {
        int fr = fr_, fq = fq_, lane = lane_; asm volatile("" : "+v"(fr), "+v"(fq), "+v"(lane));
        const int row0 = u.pm * BM + wr * 64 + fr, cin = wc * 32 + 8 * fq;
        const int mode = u.pn < 4 ? 0 : (u.pn < 8 ? 1 : 2);
        const int cbase = mode == 0 ? 128 * u.pn : (mode == 1 ? 1024 + 128 * (u.pn - 4) : 512 + 256 * (u.pn - 8));
        float rsv[2][4]; row_rstd8(ss, row0, fq, rsv);
#pragma unroll
        for (int ai = 0; ai < 2; ++ai)
#pragma unroll
            for (int m = 0; m < 4; ++m) { const int row = row0 + ai * HALF + m * 16; const float rs = rsv[ai][m];
                bf16_t* rowp = O + (size_t)row * 1536 + cbase + cin;
                f32x4 a0 = acc[ai][0][m][0] * rs, a1 = acc[ai][0][m][1] * rs, b0 = acc[ai][1][m][0] * rs, b1 = acc[ai][1][m][1] * rs;
                if (mode == 2) {
                    u32x4 w; w.x = cvt_pk_bf16(a0[0], a0[1]); w.y = cvt_pk_bf16(a0[2], a0[3]); w.z = cvt_pk_bf16(a1[0], a1[1]); w.w = cvt_pk_bf16(a1[2], a1[3]); *(u32x4*)rowp = w;
                    u32x4 x; x.x = cvt_pk_bf16(b0[0], b0[1]); x.y = cvt_pk_bf16(b0[2], b0[3]); x.z = cvt_pk_bf16(b1[0], b1[1]); x.w = cvt_pk_bf16(b1[2], b1[3]); *(u32x4*)(rowp + HALF) = x;
                } else {
                    if (mode == 0) {
#pragma unroll
                        for (int e = 0; e < 4; ++e) { b0[e] = sigm(b0[e]); b1[e] = sigm(b1[e]); } }
                    a0 = a0 * b0; a1 = a1 * b1;
                    u32x4 w; w.x = cvt_pk_bf16(a0[0], a0[1]); w.y = cvt_pk_bf16(a0[2], a0[3]); w.z = cvt_pk_bf16(a1[0], a1[1]); w.w = cvt_pk_bf16(a1[2], a1[3]); *(u32x4*)rowp = w;
                } }
    }
};
__device__ __forceinline__ float bfl(unsigned w) { return __uint_as_float(w << 16); }
__device__ __forceinline__ float bfh(unsigned w) { return __uint_as_float(w & 0xffff0000u); }
__device__ __forceinline__ void res_load(int use, const float* src, const bf16_t* hp, const bf16_t* lp, f32x4& x0, f32x4& x1) {
    if (use == 0) { x0 = *(const f32x4*)src; x1 = *(const f32x4*)(src + 4); }
    else { const u32x4 h = *(const u32x4*)hp, l = *(const u32x4*)lp;
        x0 = (f32x4){bfl(h.x) + bfl(l.x), bfh(h.x) + bfh(l.x), bfl(h.y) + bfl(l.y), bfh(h.y) + bfh(l.y)};
        x1 = (f32x4){bfl(h.z) + bfl(l.z), bfh(h.z) + bfh(l.z), bfl(h.w) + bfl(l.w), bfh(h.w) + bfh(l.w)}; }
}
__device__ __forceinline__ void res_store(bf16_t* hp, bf16_t* lp, const f32x4 x0, const f32x4 x1) {
    u32x4 h; h.x = cvt_pk_bf16(x0[0], x0[1]); h.y = cvt_pk_bf16(x0[2], x0[3]); h.z = cvt_pk_bf16(x1[0], x1[1]); h.w = cvt_pk_bf16(x1[2], x1[3]);
    u32x4 l; l.x = cvt_pk_bf16(x0[0] - bfl(h.x), x0[1] - bfh(h.x)); l.y = cvt_pk_bf16(x0[2] - bfl(h.y), x0[3] - bfh(h.y)); l.z = cvt_pk_bf16(x1[0] - bfl(h.z), x1[1] - bfh(h.z)); l.w = cvt_pk_bf16(x1[2] - bfl(h.w), x1[3] - bfh(h.w));
    *(u32x4*)hp = h; *(u32x4*)lp = l;
}
struct EpiRes {
    static constexpr bool PERM = true, AFTER_DRAIN = false;
    float* X; unsigned char* wsb; int use;
#if PROBE_OUT2 || PROBE_FF2X2
    int dry;
#endif
    __device__ __forceinline__ void operator()(f32x4 (&acc)[2][2][4][2], const Unit& u, int wr, int wc, int fr_, int fq_, int wid, int lane_) const {
        int fr = fr_, fq = fq_, lane = lane_; asm volatile("" : "+v"(fr), "+v"(fq), "+v"(lane));
#if PROBE_OUT2 || PROBE_FF2X2
        if (dry) return;
#endif
        if (u.split >= 0) {
            typedef unsigned long long u64;
            const int s = u.split, tt = (int)blockIdx.x / NS; float* part = (float*)(wsb + EPI_WS_PART); unsigned* cnt = (unsigned*)(wsb + EPI_WS_CNT) + use * 256 + tt * 8 + wid;
            u64* P = (u64*)(part + (((size_t)tt * NS + s) * 8 + wid) * 8192) + lane * 2;
#pragma unroll
            for (int q = 0; q < 4; ++q)
#pragma unroll
                for (int mm = 0; mm < 2; ++mm)
#pragma unroll
                    for (int bj = 0; bj < 2; ++bj)
#pragma unroll
                        for (int n = 0; n < 2; ++n) { const f32x4 v = acc[q >> 1][bj][2 * (q & 1) + mm][n]; u64* p = P + (q * 8 + (mm * 2 + bj) * 2 + n) * 128;
                            __hip_atomic_store(p, ((u64)__float_as_uint(v[1]) << 32) | __float_as_uint(v[0]), __ATOMIC_RELAXED, __HIP_MEMORY_SCOPE_AGENT);
                            __hip_atomic_store(p + 1, ((u64)__float_as_uint(v[3]) << 32) | __float_as_uint(v[2]), __ATOMIC_RELAXED, __HIP_MEMORY_SCOPE_AGENT); }
            asm volatile("s_waitcnt vmcnt(0)" ::: "memory");
            if (lane == 0) (void)__hip_atomic_fetch_add(cnt, 1u, __ATOMIC_RELAXED, __HIP_MEMORY_SCOPE_AGENT);
            return;
        }
        const int row0 = u.pm * BM + wr * 64 + fr, col0 = u.pn * BM + wc * 32 + 8 * fq;
        bf16_t* XB = (bf16_t*)(wsb + EPI_WS_XB); float* ssout = (float*)(wsb + EPI_WS_SS) + (size_t)(use + 1) * (18432 * 16);
        const float* xsrc = X - (u.pm < 64 ? 0 : (size_t)16384 * 1024) * 0;
        if (use == 0) { typedef const float* const __attribute__((address_space(4)))* KP; const KP ka = (KP)__builtin_amdgcn_kernarg_segment_ptr(); xsrc = (u.pm < 64) ? ka[0] : ka[1] - (size_t)16384 * 1024; }
#pragma unroll
        for (int ai = 0; ai < 2; ++ai)
#pragma unroll
            for (int m = 0; m < 4; ++m) { const int row = row0 + ai * HALF + m * 16; float sq = 0.f;
                bf16_t* bp = XB + (size_t)row * 1024 + col0; bf16_t* lp = (bf16_t*)X + (size_t)row * 2048 + 1024 + col0;
                const float* sp_ = xsrc + (size_t)row * 1024 + col0;
#pragma unroll
                for (int bj = 0; bj < 2; ++bj) { f32x4 x0, x1; res_load(use, sp_ + bj * HALF, bp + bj * HALF, lp + bj * HALF, x0, x1);
                    x0 += acc[ai][bj][m][0]; x1 += acc[ai][bj][m][1];
                    sq += (x0[0] * x0[0] + x0[1] * x0[1]) + (x0[2] * x0[2] + x0[3] * x0[3]) + (x1[0] * x1[0] + x1[1] * x1[1]) + (x1[2] * x1[2] + x1[3] * x1[3]);
                    res_store(bp + bj * HALF, lp + bj * HALF, x0, x1); }
                sq += __shfl_xor(sq, 16); sq += __shfl_xor(sq, 32);
                if (fq == 0) ssout[(size_t)row * 16 + u.pn * 4 + wc] = sq;
                if (m == 3) asm volatile("" ::: "memory"); }
    }
};
__device__ __forceinline__ void tail_job(float* X, unsigned char* wsb, int use, int job, int lane) {
    typedef unsigned long long u64;
    const int tt = job >> 5, w = (job >> 2) & 7, s = job & 3, wr = w >> 2, wc = w & 3, fr = lane & 15, fq = lane >> 4;
    float* part = (float*)(wsb + EPI_WS_PART); unsigned* cnt = (unsigned*)(wsb + EPI_WS_CNT) + use * 256 + tt * 8 + w;
    { unsigned spins = 0;
      while ((unsigned)__builtin_amdgcn_readfirstlane((int)__hip_atomic_load(cnt, __ATOMIC_RELAXED, __HIP_MEMORY_SCOPE_AGENT)) < (unsigned)NS) { __builtin_amdgcn_s_sleep(2); if (++spins > (1u << 22)) break; } }
    f32x4 v[2][2][2];
#pragma unroll
    for (int mm = 0; mm < 2; ++mm)
#pragma unroll
        for (int bj = 0; bj < 2; ++bj)
#pragma unroll
            for (int n = 0; n < 2; ++n) { f32x4 sum = (f32x4){0.f, 0.f, 0.f, 0.f};
#pragma unroll
                for (int sp = 0; sp < NS; ++sp) { const u64* qp = (const u64*)(part + (((size_t)tt * NS + sp) * 8 + w) * 8192) + lane * 2 + (s * 8 + (mm * 2 + bj) * 2 + n) * 128;
                    const u64 lo = __hip_atomic_load(qp, __ATOMIC_RELAXED, __HIP_MEMORY_SCOPE_AGENT), hi = __hip_atomic_load(qp + 1, __ATOMIC_RELAXED, __HIP_MEMORY_SCOPE_AGENT);
                    sum += (f32x4){__uint_as_float((unsigned)lo), __uint_as_float((unsigned)(lo >> 32)), __uint_as_float((unsigned)hi), __uint_as_float((unsigned)(hi >> 32))}; }
                v[mm][bj][n] = sum; }
    Unit u; StaticOrderT<4>::tile_of(256 + tt, u);
    const int ai = s >> 1, row0 = u.pm * BM + ai * HALF + wr * 64 + fr, col0 = u.pn * BM + wc * 32 + 8 * fq;
    bf16_t* XB = (bf16_t*)(wsb + EPI_WS_XB); float* ssout = (float*)(wsb + EPI_WS_SS) + (size_t)(use + 1) * (18432 * 16);
    const float* xsrc = X;
    if (use == 0) { typedef const float* const __attribute__((address_space(4)))* KP; const KP ka = (KP)__builtin_amdgcn_kernarg_segment_ptr(); xsrc = (u.pm < 64) ? ka[0] : ka[1] - (size_t)16384 * 1024; }
#pragma unroll
    for (int mm = 0; mm < 2; ++mm) { const int row = row0 + (2 * (s & 1) + mm) * 16; float sq = 0.f;
        bf16_t* bp = XB + (size_t)row * 1024 + col0; bf16_t* lp = (bf16_t*)X + (size_t)row * 2048 + 1024 + col0; const float* sp_ = xsrc + (size_t)row * 1024 + col0;
#pragma unroll
        for (int bj = 0; bj < 2; ++bj) { f32x4 x0, x1; res_load(use, sp_ + bj * HALF, bp + bj * HALF, lp + bj * HALF, x0, x1);
            x0 += v[mm][bj][0]; x1 += v[mm][bj][1];
            sq += (x0[0] * x0[0] + x0[1] * x0[1]) + (x0[2] * x0[2] + x0[3] * x0[3]) + (x1[0] * x1[0] + x1[1] * x1[1]) + (x1[2] * x1[2] + x1[3] * x1[3]);
            res_store(bp + bj * HALF, lp + bj * HALF, x0, x1); }
        sq += __shfl_xor(sq, 16); sq += __shfl_xor(sq, 32);
        if (fq == 0) ssout[(size_t)row * 16 + u.pn * 4 + wc] = sq; }
}

template <class Epi, class Sched, bool ALIGN_EPI = false, bool SP2 = false>
__device__ __forceinline__ void gemm_phase(PG8_LAS unsigned char* lds, const Gemm g, const Sched& S, const Epi& E, const int tid_in) {
    const int tid = tid_in, wid = __builtin_amdgcn_readfirstlane(tid >> 6), lane = tid & 63, wr = wid >> 2, wc = wid & 3, fr = lane & 15, fq = lane >> 4;
    const int K = g.K;
    unsigned voffA[2], voffB[2];
#pragma unroll
    for (int i = 0; i < 2; ++i) { int R, C; stage_rc(tid * 16 + i * 8192, R, C); const int Rb = Epi::PERM ? ((R & ~31) + perm32(R & 31)) : R;
        voffA[i] = (unsigned)(R * K + C) * 2u; voffB[i] = (unsigned)(Rb * K + C) * 2u; }
    const size_t kstep = (size_t)(BK * 2);
    const size_t hstep = (size_t)HALF * K * 2;
    const size_t tstep = 2 * hstep;
    const unsigned ldsw = (unsigned)wid * 1024u;
    const int aoff = lds_byte(wr * 64 + fr, fq * 8), boff = lds_byte(wc * 32 + fr, fq * 8);
#define PG8_SA(b, h) (((b) * 2 + (h)) * HTB)
#define PG8_SB(b, h) ((4 + (b) * 2 + (h)) * HTB)
#define PG8_STAGE(bufoff, gbase, voff) do { _Pragma("unroll") for (int _i = 0; _i < 2; ++_i) \
        __builtin_amdgcn_global_load_lds((const unsigned*)((const char*)(gbase) + (voff)[_i]), (PG8_LAS unsigned*)(lds + (bufoff) + ldsw + _i * 8192), 16, 0, 0); } while (0)
#define PG8_LDA(dst, b, h) do { _Pragma("unroll") for (int m = 0; m < 4; ++m) _Pragma("unroll") for (int k = 0; k < 2; ++k) dst[m][k] = *(const PG8_LAS bf16x8*)(lds + PG8_SA(b, h) + aoff + m * 2048 + k * 1024); } while (0)
#define PG8_LDB(dst, b, h) do { _Pragma("unroll") for (int n = 0; n < 2; ++n) _Pragma("unroll") for (int k = 0; k < 2; ++k) dst[n][k] = *(const PG8_LAS bf16x8*)(lds + PG8_SB(b, h) + boff + n * 2048 + k * 1024); } while (0)
#define PG8_MMA(ai, bj, At, Bt) do { __builtin_amdgcn_s_setprio(1); _Pragma("unroll") for (int m = 0; m < 4; ++m) _Pragma("unroll") for (int n = 0; n < 2; ++n) _Pragma("unroll") for (int k = 0; k < 2; ++k) \
        acc[ai][bj][m][n] = __builtin_amdgcn_mfma_f32_16x16x32_bf16(Bt[n][k], At[m][k], acc[ai][bj][m][n], 0, 0, 0); __builtin_amdgcn_s_setprio(0); } while (0)
#define PG8_WAIT_V(n) asm volatile("s_waitcnt vmcnt(" #n ")" ::: "memory")
#define PG8_WAIT_L(n) asm volatile("s_waitcnt lgkmcnt(" #n ")" ::: "memory")
#define PG8_BAR __builtin_amdgcn_s_barrier()
#define PG8_SCHED __builtin_amdgcn_sched_barrier(0)
    Unit cur, nxt; int ui = 0;
    if (!S.next(0, cur)) return;
    f32x4 acc[2][2][4][2];
#pragma unroll
    for (int a = 0; a < 2; ++a)
#pragma unroll
        for (int b = 0; b < 2; ++b)
#pragma unroll
            for (int m = 0; m < 4; ++m)
#pragma unroll
                for (int n = 0; n < 2; ++n) acc[a][b][m][n] = (f32x4){0.f, 0.f, 0.f, 0.f};
    bf16x8 At[4][2], B0[2][2], B1[2][2];
    const char* cA = (const char*)g.A + (size_t)cur.pm * tstep + (size_t)cur.kt0 * kstep; const char* cB = (const char*)g.Bt + (size_t)cur.pn * tstep + (size_t)cur.kt0 * kstep;
    S.a_ready(cur);
    if constexpr (SP2) {
        PG8_STAGE(PG8_SB(0, 0), cB, voffB); PG8_STAGE(PG8_SB(0, 1), cB + hstep, voffB); PG8_STAGE(PG8_SA(0, 0), cA, voffA); PG8_STAGE(PG8_SA(0, 1), cA + hstep, voffA);
        if (wr == 1) PG8_BAR;
        PG8_WAIT_V(2); PG8_BAR;
        PG8_STAGE(PG8_SB(1, 0), cB + kstep, voffB); PG8_STAGE(PG8_SA(1, 0), cA + kstep, voffA); PG8_STAGE(PG8_SB(1, 1), cB + hstep + kstep, voffB);
        PG8_WAIT_V(6); PG8_BAR;
    } else {
        PG8_STAGE(PG8_SB(0, 0), cB, voffB); PG8_STAGE(PG8_SA(0, 0), cA, voffA); PG8_STAGE(PG8_SB(0, 1), cB + hstep, voffB); PG8_STAGE(PG8_SA(0, 1), cA + hstep, voffA);
        if (wr == 1) PG8_BAR;
        PG8_WAIT_V(4); PG8_BAR;
        PG8_STAGE(PG8_SB(1, 0), cB + kstep, voffB); PG8_STAGE(PG8_SA(1, 0), cA + kstep, voffA); PG8_STAGE(PG8_SB(1, 1), cB + hstep + kstep, voffB);
        PG8_WAIT_V(6); PG8_BAR;
    }
    for (;;) {
        const bool has_next = S.next(ui + 1, nxt);
        const char* nA = has_next ? (const char*)g.A + (size_t)nxt.pm * tstep + (size_t)nxt.kt0 * kstep : cA; const char* nB = has_next ? (const char*)g.Bt + (size_t)nxt.pn * tstep + (size_t)nxt.kt0 * kstep : cB;
        const int nt = cur.nkt;
        for (int t = 0; t < nt; t += 2) {
            const bool last = (t == nt - 2);
            const char* a1 = cA + (size_t)(t + 1) * kstep;
            const char* a2 = last ? nA : cA + (size_t)(t + 2) * kstep; const char* b2 = last ? nB : cB + (size_t)(t + 2) * kstep;
            const char* a3 = a2 + kstep; const char* b3 = b2 + kstep;
            if (last && has_next) S.a_ready(nxt);
            if constexpr (SP2) {
            PG8_LDB(B0, 0, 0); PG8_LDB(B1, 0, 1); PG8_SCHED; PG8_LDA(At, 0, 0); PG8_STAGE(PG8_SA(1, 1), a1 + hstep, voffA);
            PG8_WAIT_V(8); PG8_WAIT_L(0); PG8_BAR; PG8_MMA(0, 0, At, B0); PG8_MMA(0, 1, At, B1); PG8_BAR; PG8_SCHED;
            PG8_LDA(At, 0, 1); PG8_STAGE(PG8_SB(0, 0), b2, voffB); PG8_STAGE(PG8_SB(0, 1), b2 + hstep, voffB); PG8_STAGE(PG8_SA(0, 0), a2, voffA);
            PG8_WAIT_V(8); PG8_WAIT_L(0); PG8_BAR; PG8_MMA(1, 0, At, B0); PG8_MMA(1, 1, At, B1); PG8_BAR; PG8_SCHED;
            PG8_LDB(B0, 1, 0); PG8_LDB(B1, 1, 1); PG8_SCHED; PG8_LDA(At, 1, 0); PG8_STAGE(PG8_SA(0, 1), a2 + hstep, voffA);
            PG8_WAIT_V(8); PG8_WAIT_L(0); PG8_BAR; PG8_MMA(0, 0, At, B0); PG8_MMA(0, 1, At, B1); PG8_BAR; PG8_SCHED;
            PG8_LDA(At, 1, 1); PG8_STAGE(PG8_SB(1, 0), b3, voffB); PG8_STAGE(PG8_SB(1, 1), b3 + hstep, voffB); PG8_STAGE(PG8_SA(1, 0), a3, voffA);
            PG8_WAIT_V(8); PG8_WAIT_L(0); PG8_BAR; PG8_MMA(1, 0, At, B0); PG8_MMA(1, 1, At, B1); PG8_BAR; PG8_SCHED;
            } else {
            PG8_LDB(B0, 0, 0); PG8_SCHED; PG8_LDA(At, 0, 0); PG8_STAGE(PG8_SA(1, 1), a1 + hstep, voffA);
            PG8_WAIT_L(8); PG8_BAR; PG8_WAIT_L(0); PG8_MMA(0, 0, At, B0); PG8_BAR; PG8_SCHED;
            PG8_LDB(B1, 0, 1); PG8_STAGE(PG8_SB(0, 0), b2, voffB);
            PG8_BAR; PG8_WAIT_L(0); PG8_MMA(0, 1, At, B1); PG8_BAR;
            PG8_LDA(At, 0, 1); PG8_STAGE(PG8_SA(0, 0), a2, voffA);
            PG8_BAR; PG8_WAIT_L(0); PG8_MMA(1, 0, At, B0); PG8_BAR; PG8_SCHED;
            PG8_STAGE(PG8_SB(0, 1), b2 + hstep, voffB);
            PG8_WAIT_V(6); PG8_BAR; PG8_MMA(1, 1, At, B1); PG8_BAR;
            PG8_LDB(B0, 1, 0); PG8_SCHED; PG8_LDA(At, 1, 0); PG8_STAGE(PG8_SA(0, 1), a2 + hstep, voffA);
            PG8_WAIT_L(8); PG8_BAR; PG8_WAIT_L(0); PG8_MMA(0, 0, At, B0); PG8_BAR; PG8_SCHED;
            PG8_LDB(B1, 1, 1); PG8_STAGE(PG8_SB(1, 0), b3, voffB);
            PG8_BAR; PG8_WAIT_L(0); PG8_MMA(0, 1, At, B1); PG8_BAR;
            PG8_LDA(At, 1, 1); PG8_STAGE(PG8_SA(1, 0), a3, voffA);
            PG8_BAR; PG8_WAIT_L(0); PG8_MMA(1, 0, At, B0); PG8_BAR; PG8_SCHED;
            PG8_STAGE(PG8_SB(1, 1), b3 + hstep, voffB);
            PG8_WAIT_V(6); PG8_BAR; PG8_MMA(1, 1, At, B1); PG8_BAR;
            }
        }
        if constexpr (ALIGN_EPI) { if (wr == 0) PG8_BAR; }
        if constexpr (!Epi::AFTER_DRAIN) { E(acc, cur, wr, wc, fr, fq, wid, lane); S.done(cur); }
        if (!has_next) break;
#pragma unroll
        for (int a = 0; a < 2; ++a)
#pragma unroll
            for (int b = 0; b < 2; ++b)
#pragma unroll
                for (int m = 0; m < 4; ++m)
#pragma unroll
                    for (int n = 0; n < 2; ++n) acc[a][b][m][n] = (f32x4){0.f, 0.f, 0.f, 0.f};
        cur = nxt; cA = nA; cB = nB; ++ui;
        if constexpr (ALIGN_EPI) { if (wr == 1) PG8_BAR; }
    }
    PG8_WAIT_V(0);
    if constexpr (!ALIGN_EPI) { if (wr == 0) PG8_BAR; }
    PG8_BAR;
    if constexpr (Epi::AFTER_DRAIN) { E.fused(acc, cur, wr, wc, fr, fq, lds, wid, lane); S.done(cur); }
#undef PG8_SA
#undef PG8_SB
#undef PG8_STAGE
#undef PG8_LDA
#undef PG8_LDB
#undef PG8_MMA
#undef PG8_WAIT_V
#undef PG8_WAIT_L
#undef PG8_BAR
#undef PG8_SCHED
}
}

namespace cg = cooperative_groups;
#define GAS __attribute__((address_space(1)))
#define LAS __attribute__((address_space(3)))
typedef unsigned short bf16;
typedef unsigned v4u __attribute__((ext_vector_type(4)));
typedef unsigned v2u __attribute__((ext_vector_type(2)));
typedef float f32x4 __attribute__((ext_vector_type(4)));
typedef float f32x2 __attribute__((ext_vector_type(2)));
typedef short bf16x8 __attribute__((ext_vector_type(8)));

constexpr int NWAVES = 8, NTHR = 512;
constexpr int D = 1024, MP = 16384, MS = 2048, M = MP + MS, FF = 4096, EVEN_IN = 1536, ODD_IN = 2560, SEQ = 8192;
constexpr float EPS = 1e-6f;
constexpr int LDS_BYTES = 147456;
constexpr size_t MiB = 1u << 20;
constexpr size_t WS_SS = 206 * MiB;
constexpr size_t WS_WIN = 1 * MiB;
constexpr size_t WS_WOUT = 6 * MiB;
constexpr size_t WS_WFF1 = 10 * MiB;
constexpr size_t WS_WFF2 = 18 * MiB;
constexpr size_t WS_XB = 26 * MiB;
constexpr size_t WS_H = 62 * MiB;
constexpr size_t WS_Z = WS_H;
constexpr size_t WS_MIX = 152 * MiB;
constexpr size_t WS_PART = 218 * MiB;
constexpr size_t WS_CNT = 250 * MiB;
constexpr size_t CNT_BYTES = 8 * 256 * 4;
constexpr size_t WS_BAR = WS_CNT + CNT_BYTES;
constexpr size_t WS_RDY = WS_CNT + 22528;
constexpr size_t ZERO_BYTES = 24576;
static_assert(WS_BAR + 3456 * 4 <= WS_RDY && WS_RDY + 4 * 72 * 4 <= WS_CNT + ZERO_BYTES, "control words inside the memset region");
constexpr size_t WS_VST = 251 * MiB;
constexpr size_t WS_END = 253 * MiB;
static_assert(pg8::NS == 4, "partial buffer sized for 4 slices");
static_assert(pg8::EPI_WS_XB == WS_XB && pg8::EPI_WS_SS == WS_SS && pg8::EPI_WS_PART == WS_PART && pg8::EPI_WS_CNT == WS_CNT, "epilogue view of the d_ws map");
constexpr size_t O_Y = 0, O_POOL_P = (size_t)M * D, O_CC_P = O_POOL_P + 2 * 2 * 15 * 512, O_CD_P = O_CC_P + 2 * 2 * 30 * 512, O_AV_S = O_CD_P + 2 * 2 * 2 * 512,
                 O_POOL_S = O_AV_S + (size_t)2 * 32 * 64 * 512, O_CC_S = O_POOL_S + 2 * 32 * 15 * 512, O_CD_S = O_CC_S + 2 * 32 * 30 * 512, O_END = O_CD_S + 2 * 32 * 2 * 512;
static_assert(O_END == 22607872, "output size");

__device__ __forceinline__ float wave_sum(float v) {
#pragma unroll
    for (int o = 1; o < 64; o <<= 1) v += __shfl_xor(v, o);
    return v;
}
__device__ __forceinline__ unsigned pk2(float lo, float hi) { return pg8::cvt_pk_bf16(lo, hi); }
__device__ __forceinline__ float bflo(unsigned w) { return __uint_as_float(w << 16); }
__device__ __forceinline__ float bfhi(unsigned w) { return __uint_as_float(w & 0xffff0000u); }
__device__ __forceinline__ void unpack8(const v4u w, f32x4& a, f32x4& b) { a = (f32x4){bflo(w.x), bfhi(w.x), bflo(w.y), bfhi(w.y)}; b = (f32x4){bflo(w.z), bfhi(w.z), bflo(w.w), bfhi(w.w)}; }
__device__ __forceinline__ v4u pack8(const f32x4 a, const f32x4 b) { v4u w; w.x = pk2(a[0], a[1]); w.y = pk2(a[2], a[3]); w.z = pk2(b[0], b[1]); w.w = pk2(b[2], b[3]); return w; }
__device__ __forceinline__ void st_wt16(bf16* p, const v4u v) { asm volatile("global_store_dwordx4 %0, %1, off sc1" :: "v"(p), "v"(v) : "memory"); }
__device__ __forceinline__ void st_wt8(bf16* p, const v2u v) { asm volatile("global_store_dwordx2 %0, %1, off sc1" :: "v"(p), "v"(v) : "memory"); }
__device__ __forceinline__ float sigmoidf_(float g) { return __builtin_amdgcn_rcpf(1.0f + __builtin_amdgcn_exp2f(g * -1.4426950409f)); }

__device__ __forceinline__ int odd_src_col(int n0) { const int p = n0 >> 8, hf = (n0 >> 7) & 1, j = n0 & 127; return p < 4 ? hf * 512 + 128 * p + j : (p < 8 ? 1536 + hf * 512 + 128 * (p - 4) + j : 1024 + (n0 - 2048)); }
__device__ __forceinline__ void cvt_item(const float* W, int K, int N, const float* gk, bf16* WT, LAS float* scr, int item, int lane, bool remap = false) {
    const int nblk = N / 32, kb = item / nblk, nb = item % nblk, k0 = 64 * kb, n0 = 32 * nb, s0 = remap ? odd_src_col(n0) : n0;
#pragma unroll 1
    for (int hb = 0; hb < 2; ++hb) {
        float wv[16]; const float* wp = W + (size_t)(k0 + 32 * hb + (lane >> 5)) * N + s0 + (lane & 31);
#pragma unroll
        for (int i = 0; i < 16; ++i) wv[i] = wp[(size_t)(2 * i) * N];
#pragma unroll
        for (int i = 0; i < 16; ++i) { const int kk = 32 * hb + 2 * i + (lane >> 5); float w = wv[i]; if (gk) w *= gk[k0 + kk]; scr[kk * 33 + (lane & 31)] = w; }
    }
    asm volatile("s_waitcnt lgkmcnt(0)" ::: "memory");
    const int c = lane & 7;
#pragma unroll
    for (int j = 0; j < 4; ++j) { const int n = (lane >> 3) + 8 * j; const LAS float* s = scr + (8 * c) * 33 + n;
        v4u o; o.x = pk2(s[0 * 33], s[1 * 33]); o.y = pk2(s[2 * 33], s[3 * 33]); o.z = pk2(s[4 * 33], s[5 * 33]); o.w = pk2(s[6 * 33], s[7 * 33]);
        *(v4u*)(WT + (size_t)(n0 + n) * K + k0 + 8 * c) = o; }
    asm volatile("s_waitcnt lgkmcnt(0)" ::: "memory");
}
__device__ __forceinline__ void fold_item(const float* Wo, const float* pw, const float* bs, bf16* WT, LAS float* scr, int item, int lane) {
    const int nb = item & 31, ch = (item >> 5) & 1, g = item >> 6, n0 = nb * 32, c = ch * 64 + lane;
    { const int n = lane & 31, dh = lane >> 5; const float* wp = Wo + (size_t)(512 + g * 128 + dh) * 1024 + n0 + n; const float* sp = bs + g * 128 + dh;
#pragma unroll 1
      for (int b = 0; b < 4; ++b) { float wv[16], sv[16];
#pragma unroll
          for (int i = 0; i < 16; ++i) { wv[i] = wp[(size_t)(2 * (b * 16 + i)) * 1024]; sv[i] = sp[2 * (b * 16 + i)]; }
#pragma unroll
          for (int i = 0; i < 16; ++i) scr[(2 * (b * 16 + i) + dh) * 32 + n] = wv[i] * sv[i]; } }
    asm volatile("s_waitcnt lgkmcnt(0)" ::: "memory");
    f32x4 acc[8];
#pragma unroll
    for (int i = 0; i < 8; ++i) acc[i] = (f32x4){0.f, 0.f, 0.f, 0.f};
    const float* pr = pw + ((size_t)g * 128 + c) * 128;
#pragma unroll 1
    for (int d0 = 0; d0 < 128; d0 += 32) { f32x4 pv[8];
#pragma unroll
        for (int j = 0; j < 8; ++j) pv[j] = *(const f32x4*)(pr + d0 + 4 * j);
#pragma unroll
        for (int j = 0; j < 8; ++j)
#pragma unroll
            for (int dd = 0; dd < 4; ++dd)
#pragma unroll
                for (int n4 = 0; n4 < 8; ++n4) { const f32x4 w = *(const LAS f32x4*)(scr + (d0 + 4 * j + dd) * 32 + n4 * 4); acc[n4] += w * pv[j][dd]; } }
#pragma unroll
    for (int n4 = 0; n4 < 8; ++n4)
#pragma unroll
        for (int e = 0; e < 4; ++e) WT[(size_t)(n0 + n4 * 4 + e) * 1024 + 512 + g * 128 + c] = (bf16)(pk2(acc[n4][e], 0.f) & 0xffffu);
    asm volatile("s_waitcnt lgkmcnt(0)" ::: "memory");
}

struct Args { const float* in[25]; float* out; unsigned char* ws; };
typedef const __attribute__((address_space(4))) Args* CArgs;
#define LAUNDER_V(x) asm volatile("" : "+v"(x))
#define LAUNDER_S(x) asm volatile("" : "+s"(x))

__device__ __forceinline__ int cvt_count(int kind, int layer) {
    if (kind == 0) return (layer & 1) ? 16 * (ODD_IN / 32) : 16 * (EVEN_IN / 32);
    if (kind == 1) return (layer & 1) ? 16 * 32 : 8 * 32 + 256;
    if (kind == 2) return 16 * (FF / 32);
    return (FF / 64) * 32;
}
__device__ __forceinline__ void cvt_do(CArgs A, int kind, int layer, int item, LAS float* scr, int lane) {
    unsigned char* ws = A->ws; const int i = layer >> 1;
    if (kind == 0) {
        if (layer & 1) cvt_item(A->in[16] + (size_t)i * D * ODD_IN, D, ODD_IN, A->in[5] + layer * D, (bf16*)(ws + WS_WIN), scr, item, lane, true);
        else cvt_item(A->in[8] + (size_t)i * D * EVEN_IN, D, EVEN_IN, A->in[5] + layer * D, (bf16*)(ws + WS_WIN), scr, item, lane);
    } else if (kind == 1) {
        bf16* wt = (bf16*)(ws + WS_WOUT + (size_t)(layer & 1) * 2 * MiB);
        if (layer & 1) cvt_item(A->in[17] + (size_t)i * D * D, D, D, nullptr, wt, scr, item, lane);
        else { if (item < 256) cvt_item(A->in[9] + (size_t)i * D * D, D, D, nullptr, wt, scr, item, lane);
               else fold_item(A->in[9] + (size_t)i * D * D, A->in[14] + (size_t)i * 4 * 128 * 128, A->in[15] + i * 512, wt, scr, item - 256, lane); }
    } else if (kind == 2) cvt_item(A->in[23] + (size_t)layer * D * FF, D, FF, A->in[6] + layer * D, (bf16*)(ws + WS_WFF1), scr, item, lane);
    else cvt_item(A->in[24] + (size_t)layer * FF * D, FF, D, nullptr, (bf16*)(ws + WS_WFF2), scr, item, lane);
}
__device__ __forceinline__ void cvt_run(CArgs A, int nk, int k0, int l0, int k1, int l1, int k2, int l2, int k3, int l3, LAS unsigned char* lds, int gw, int NGW, int wave, int lane) {
    LAS float* scr = (LAS float*)(lds + wave * 16384);
    const int c0 = cvt_count(k0, l0), c1 = nk > 1 ? cvt_count(k1, l1) : 0, c2 = nk > 2 ? cvt_count(k2, l2) : 0, c3 = nk > 3 ? cvt_count(k3, l3) : 0;
    const int tot = c0 + c1 + c2 + c3;
    for (int it = gw; it < tot; it += NGW) {
        int r = it;
        if (r < c0) { cvt_do(A, k0, l0, r, scr, lane); continue; } r -= c0;
        if (r < c1) { cvt_do(A, k1, l1, r, scr, lane); continue; } r -= c1;
        if (r < c2) { cvt_do(A, k2, l2, r, scr, lane); continue; } r -= c2;
        cvt_do(A, k3, l3, r, scr, lane);
    }
}

constexpr int VS_STRIDE = 66;
constexpr int ZE = 1536;
template <int WIN> __device__ __forceinline__ void pool_rows(const bf16* Z, bf16* MIX, const float* hist, float* pout, int rbase, int tfirst, int lr0, int colx, bool sample, bool lastchunk) {
    v4u x[WIN + 7];
#pragma unroll
    for (int k = 0; k < WIN + 7; ++k) { const int t = tfirst - WIN + 1 + k;
        if (t >= 0) x[k] = *(const v4u*)(Z + (size_t)(rbase + t) * ZE + 1024 + colx);
        else if (sample) { const float* hp = hist + (size_t)(15 + t) * 512; x[k] = pack8(*(const f32x4*)hp, *(const f32x4*)(hp + 4)); }
        else x[k] = (v4u){0u, 0u, 0u, 0u}; }
    f32x4 s0 = (f32x4){0.f, 0.f, 0.f, 0.f}, s1 = s0;
#pragma unroll
    for (int k = 0; k < WIN; ++k) { f32x4 a, b; unpack8(x[k], a, b); s0 += a; s1 += b; }
#pragma unroll
    for (int i = 0; i < 8; ++i) {
        const int t = tfirst + i; f32x4 xa, xb; unpack8(x[WIN - 1 + i], xa, xb);
        const int cnti = sample ? WIN : (t + 1 < WIN ? t + 1 : WIN);
        const float inv = 1.0f / (float)cnti;
        st_wt16(MIX + (size_t)(rbase + t) * D + 512 + colx, pack8(s0 * inv - xa, s1 * inv - xb));
        if (lastchunk && lr0 + i >= 49) { float* po = pout + (size_t)(lr0 + i - 49) * 512; *(f32x4*)po = xa; *(f32x4*)(po + 4) = xb; }
        if (i < 7) { f32x4 na, nb, oa, ob; unpack8(x[WIN + i], na, nb); unpack8(x[i], oa, ob); s0 += na - oa; s1 += nb - ob; }
    }
}
__device__ __forceinline__ void even_unit(CArgs A, int ie, int q, LAS unsigned char* lds, int tid, int wave, int lane) {
    const bf16* Z = (const bf16*)(A->ws + WS_Z); bf16* MIX = (bf16*)(A->ws + WS_MIX); const float* VST = (const float*)(A->ws + WS_VST);
    const int row0 = q * 64; const bool sample = row0 >= MP;
    int t0, half, seq;
    if (!sample) { t0 = row0 & (SEQ - 1); half = (t0 >> 6) & 1; seq = row0 >> 13; } else { t0 = 0; half = 0; seq = (row0 - MP) >> 6; }
    const int nj = 64 * (half + 1), jrow0 = row0 - 64 * half, ioff = 64 * half;
    LAS f32x2* stat = (LAS f32x2*)(lds + 8 * 128 * VS_STRIDE * 2);
    LAS bf16* Vs = (LAS bf16*)lds + wave * 128 * VS_STRIDE;
    __syncthreads();
    if (tid < nj) {
        const float* vp = VST + (size_t)(jrow0 + tid) * 16;
        const f32x4 p0 = *(const f32x4*)vp, p1 = *(const f32x4*)(vp + 4), p2 = *(const f32x4*)(vp + 8), p3 = *(const f32x4*)(vp + 12);
        const float s = ((p0[0] + p0[2]) + (p1[0] + p1[2])) + ((p2[0] + p2[2]) + (p3[0] + p3[2])), qq = ((p0[1] + p0[3]) + (p1[1] + p1[3])) + ((p2[1] + p2[3]) + (p3[1] + p3[3]));
        const float mean = s * (1.0f / 512.0f), var = fmaxf(qq * (1.0f / 512.0f) - mean * mean, 0.f);
        stat[tid] = (f32x2){mean, __builtin_amdgcn_rsqf(var + EPS)};
    }
    __syncthreads();
    const int h = wave;
    {
        const int c8 = (lane & 7) * 8;
        const float* gp = A->in[12] + ie * 512 + h * 64 + c8; const float* bp = A->in[13] + ie * 512 + h * 64 + c8;
        const f32x4 g0 = *(const f32x4*)gp, g1 = *(const f32x4*)(gp + 4), b0 = *(const f32x4*)bp, b1 = *(const f32x4*)(bp + 4);
        for (int bb = 0; bb < nj / 64; ++bb) {
            v4u w[8];
#pragma unroll
            for (int i = 0; i < 8; ++i) w[i] = *(const v4u*)(Z + (size_t)(jrow0 + bb * 64 + i * 8 + (lane >> 3)) * ZE + 512 + h * 64 + c8);
#pragma unroll
            for (int i = 0; i < 8; ++i) {
                const int r = bb * 64 + i * 8 + (lane >> 3); f32x4 a, b; unpack8(w[i], a, b);
                const f32x2 st = stat[r];
                a = (a - st.x) * st.y * g0 + b0; b = (b - st.x) * st.y * g1 + b1;
                const v4u o = pack8(a, b);
                LAS unsigned* dst = (LAS unsigned*)(Vs + r * VS_STRIDE + c8);
                dst[0] = o.x; dst[1] = o.y; dst[2] = o.z; dst[3] = o.w;
                if (sample) { float* vo = A->out + O_AV_S + ((size_t)(ie * 32 + seq) * 64 + r) * 512 + h * 64 + c8; *(f32x4*)vo = a; *(f32x4*)(vo + 4) = b; }
            }
        }
    }
    asm volatile("s_waitcnt lgkmcnt(0)" ::: "memory");
    {
        const int fr = lane & 15, fq = lane >> 4;
        f32x4 acc[4][4];
#pragma unroll
        for (int a = 0; a < 4; ++a)
#pragma unroll
            for (int b = 0; b < 4; ++b) acc[a][b] = (f32x4){0.f, 0.f, 0.f, 0.f};
        const float* Wh = A->in[10] + ((size_t)(ie * 8 + h) * 128 + ioff) * 128 + (size_t)fr * 128 + 8 * fq;
        v2u uw[4][4]; float bias[4];
#pragma unroll
        for (int it = 0; it < 4; ++it) { bias[it] = A->in[11][(ie * 8 + h) * 128 + ioff + it * 16 + fr];
#pragma unroll
            for (int ct = 0; ct < 4; ++ct) uw[it][ct] = *(const v2u*)(Z + (size_t)(row0 + it * 16 + fr) * ZE + h * 64 + ct * 16 + 4 * fq); }
        f32x4 wn[4][2];
#pragma unroll
        for (int it = 0; it < 4; ++it) { wn[it][0] = *(const f32x4*)(Wh + it * 16 * 128); wn[it][1] = *(const f32x4*)(Wh + it * 16 * 128 + 4); }
        const int nks = nj / 32;
        for (int ks = 0; ks < nks; ++ks) {
            bf16x8 av[4], bv[4];
#pragma unroll
            for (int it = 0; it < 4; ++it) { const v4u pk = pack8(wn[it][0], wn[it][1]); bv[it] = __builtin_bit_cast(bf16x8, pk); }
            if (ks + 1 < nks) {
#pragma unroll
                for (int it = 0; it < 4; ++it) { wn[it][0] = *(const f32x4*)(Wh + it * 16 * 128 + (ks + 1) * 32); wn[it][1] = *(const f32x4*)(Wh + it * 16 * 128 + (ks + 1) * 32 + 4); } }
#pragma unroll
            for (int ct = 0; ct < 4; ++ct) {
                const LAS bf16* p = Vs + (ks * 32 + 8 * fq) * VS_STRIDE + ct * 16 + fr;
#pragma unroll
                for (int e = 0; e < 8; ++e) av[ct][e] = (short)p[e * VS_STRIDE];
            }
#pragma unroll
            for (int ct = 0; ct < 4; ++ct)
#pragma unroll
                for (int it = 0; it < 4; ++it) acc[ct][it] = __builtin_amdgcn_mfma_f32_16x16x32_bf16(av[ct], bv[it], acc[ct][it], 0, 0, 0);
        }
#pragma unroll
        for (int it = 0; it < 4; ++it) {
            const int row = row0 + it * 16 + fr;
#pragma unroll
            for (int ct = 0; ct < 4; ++ct) {
                const int col = h * 64 + ct * 16 + 4 * fq;
                const f32x4 uu = (f32x4){bflo(uw[it][ct].x), bfhi(uw[it][ct].x), bflo(uw[it][ct].y), bfhi(uw[it][ct].y)};
                const f32x4 y = uu * (acc[ct][it] + bias[it]);
                v2u o; o.x = pk2(y[0], y[1]); o.y = pk2(y[2], y[3]);
                st_wt8(MIX + (size_t)row * D + col, o);
            }
        }
    }
    {
        const int g = wave & 3, rh = wave >> 2, cb = lane & 15, rs = lane >> 4;
        const int colx = g * 128 + cb * 8;
        const int rbase = row0 - t0;
        const bool lastchunk = sample || (t0 == SEQ - 64);
        const float* hist = A->in[2] + ((size_t)(ie * 32 + seq) * 15) * 512 + colx;
        float* pout = sample ? (A->out + O_POOL_S + ((size_t)(ie * 32 + seq) * 15) * 512 + colx) : (A->out + O_POOL_P + ((size_t)(ie * 2 + seq) * 15) * 512 + colx);
        const int lr0 = 32 * rh + 8 * rs, tfirst = t0 + lr0;
        if (g == 0) pool_rows<2>(Z, MIX, hist, pout, rbase, tfirst, lr0, colx, sample, lastchunk);
        else if (g == 1) pool_rows<4>(Z, MIX, hist, pout, rbase, tfirst, lr0, colx, sample, lastchunk);
        else if (g == 2) pool_rows<8>(Z, MIX, hist, pout, rbase, tfirst, lr0, colx, sample, lastchunk);
        else pool_rows<16>(Z, MIX, hist, pout, rbase, tfirst, lr0, colx, sample, lastchunk);
    }
}

__device__ __forceinline__ void odd_unit(CArgs A, int io, int q, LAS unsigned char* lds, int tid, int wave, int lane) {
    const bf16* Z = (const bf16*)(A->ws + WS_Z); bf16* MIX = (bf16*)(A->ws + WS_MIX);
    const int row0 = q * 64; const bool sample = row0 >= MP;
    int t0, seq;
    if (!sample) { t0 = row0 & (SEQ - 1); seq = row0 >> 13; } else { t0 = 0; seq = (row0 - MP) >> 6; }
    const int rbase = row0 - t0; const int T = sample ? 64 : SEQ; const bool lastchunk = sample || (t0 == SEQ - 64);
    LAS bf16* cin = (LAS bf16*)lds;
    LAS float* cbuf = (LAS float*)(lds + 94 * 1024);
    {
        const int cb = tid & 63, rg = tid >> 6, ch = cb * 8;
        const float* dw = A->in[22] + (size_t)io * 3 * 512 + ch;
        const f32x4 w0a = *(const f32x4*)dw, w0b = *(const f32x4*)(dw + 4), w1a = *(const f32x4*)(dw + 512), w1b = *(const f32x4*)(dw + 516), w2a = *(const f32x4*)(dw + 1024), w2b = *(const f32x4*)(dw + 1028);
        const float* hd = A->in[4] + ((size_t)(io * 32 + seq) * 2) * 512 + ch;
        float* dout = sample ? (A->out + O_CD_S + ((size_t)(io * 32 + seq) * 2) * 512 + ch) : (A->out + O_CD_P + ((size_t)(io * 2 + seq) * 2) * 512 + ch);
        const int tf = t0 + 8 * rg;
        v4u dgw[10], gbw[8];
#pragma unroll
        for (int k = 0; k < 10; ++k) { const int t = tf - 2 + k;
            if (t >= 0) dgw[k] = *(const v4u*)(Z + (size_t)(rbase + t) * ZE + 1024 + ch);
            else if (sample) { const float* hp = hd + (size_t)(2 + t) * 512; dgw[k] = pack8(*(const f32x4*)hp, *(const f32x4*)(hp + 4)); }
            else dgw[k] = (v4u){0u, 0u, 0u, 0u}; }
#pragma unroll
        for (int i = 0; i < 8; ++i) gbw[i] = *(const v4u*)(Z + (size_t)(rbase + tf + i) * ZE + 512 + ch);
        f32x4 m2a, m2b, m1a, m1b; unpack8(dgw[0], m2a, m2b); unpack8(dgw[1], m1a, m1b);
#pragma unroll
        for (int i = 0; i < 8; ++i) {
            const int t = tf + i; f32x4 da, db, ga, gb; unpack8(dgw[2 + i], da, db); unpack8(gbw[i], ga, gb);
            const f32x4 ya = ga * (w0a * m2a + w1a * m1a + w2a * da), yb = gb * (w0b * m2b + w1b * m1b + w2b * db);
            st_wt16(MIX + (size_t)(rbase + t) * D + 512 + ch, pack8(ya, yb));
            const int lr = 8 * rg + i;
            if (lastchunk && lr >= 62) { float* po = dout + (size_t)(lr - 62) * 512; *(f32x4*)po = da; *(f32x4*)(po + 4) = db; }
            m2a = m1a; m2b = m1b; m1a = da; m1b = db;
        }
    }
    __syncthreads();
    {
        const float* hc = A->in[3] + ((size_t)(io * 32 + seq) * 30) * 512;
        float* cout = sample ? (A->out + O_CC_S + ((size_t)(io * 32 + seq) * 30) * 512) : (A->out + O_CC_P + ((size_t)(io * 2 + seq) * 30) * 512);
        for (int base = tid; base < 94 * 64; base += 4 * NTHR) {
            v4u w[4];
#pragma unroll
            for (int u = 0; u < 4; ++u) { const int item = base + u * NTHR, lr = item >> 6, cb = item & 63, t = t0 + lr - 30;
                if (item < 94 * 64 && t >= 0) w[u] = *(const v4u*)(Z + (size_t)(rbase + t) * ZE + cb * 8);
                else if (item < 94 * 64 && sample) { const float* hp = hc + (size_t)(30 + t) * 512 + cb * 8; w[u] = pack8(*(const f32x4*)hp, *(const f32x4*)(hp + 4)); }
                else w[u] = (v4u){0u, 0u, 0u, 0u}; }
#pragma unroll
            for (int u = 0; u < 4; ++u) { const int item = base + u * NTHR, lr = item >> 6, cb = item & 63, t = t0 + lr - 30;
                if (item < 94 * 64) {
                    *(LAS v4u*)(cin + lr * 512 + cb * 8) = w[u];
                    if (lastchunk && lr >= 30 && t >= T - 30) { f32x4 a, b; unpack8(w[u], a, b); float* po = cout + (size_t)(t - (T - 30)) * 512 + cb * 8; *(f32x4*)po = a; *(f32x4*)(po + 4) = b; } } }
        }
    }
    __syncthreads();
    {
        const int cp = tid & 255, rq = tid >> 8;
        f32x2 w[31];
#pragma unroll
        for (int k = 0; k < 31; ++k) w[k] = *(const f32x2*)(A->in[18] + ((size_t)io * 31 + k) * 512 + 2 * cp);
        const f32x2 cbias = *(const f32x2*)(A->in[19] + io * 512 + 2 * cp);
        const float* lg = A->in[20] + io * 512 + lane * 8; const float* lb = A->in[21] + io * 512 + lane * 8;
        const f32x4 g0 = *(const f32x4*)lg, g1 = *(const f32x4*)(lg + 4), b0 = *(const f32x4*)lb, b1 = *(const f32x4*)(lb + 4);
        for (int sb = 0; sb < 4; ++sb) {
            const int r0 = 16 * sb + 8 * rq;
            f32x2 acc[8];
#pragma unroll
            for (int i = 0; i < 8; ++i) acc[i] = cbias;
#pragma unroll
            for (int j = 0; j < 38; ++j) { const unsigned xw = *(const LAS unsigned*)(cin + (r0 + j) * 512 + 2 * cp); const f32x2 x = (f32x2){bflo(xw), bfhi(xw)};
#pragma unroll
                for (int i = 0; i < 8; ++i) { if (j - i >= 0 && j - i < 31) acc[i] += w[j - i] * x; } }
#pragma unroll
            for (int i = 0; i < 8; ++i) *(LAS f32x2*)(cbuf + (8 * rq + i) * 512 + 2 * cp) = acc[i];
            __syncthreads();
#pragma unroll
            for (int rr = 0; rr < 2; ++rr) {
                const int lr = 2 * wave + rr;
                f32x4 a = *(const LAS f32x4*)(cbuf + lr * 512 + lane * 8), b = *(const LAS f32x4*)(cbuf + lr * 512 + lane * 8 + 4);
                const float s = wave_sum((a[0] + a[1]) + (a[2] + a[3]) + (b[0] + b[1]) + (b[2] + b[3]));
                const float mean = s * (1.0f / 512.0f);
                a = a - mean; b = b - mean;
                const float qq = wave_sum((a[0] * a[0] + a[1] * a[1]) + (a[2] * a[2] + a[3] * a[3]) + (b[0] * b[0] + b[1] * b[1]) + (b[2] * b[2] + b[3] * b[3]));
                const float rstd = __builtin_amdgcn_rsqf(qq * (1.0f / 512.0f) + EPS);
                a = a * rstd * g0 + b0; b = b * rstd * g1 + b1;
#pragma unroll
                for (int e = 0; e < 4; ++e) { a[e] = a[e] * sigmoidf_(a[e]); b[e] = b[e] * sigmoidf_(b[e]); }
                st_wt16(MIX + (size_t)(row0 + 16 * sb + lr) * D + lane * 8, pack8(a, b));
            }
            __syncthreads();
        }
    }
}

#define RLX_AGENT __ATOMIC_RELAXED, __HIP_MEMORY_SCOPE_AGENT
#define XB_TMO      128
#define XB_XCNT(j)  (256  + 64 * (j))
#define XB_XSUB(j)  (1280 + 64 * (j))
#define XB_XGEN(j)  (2304 + 64 * (j))
#define XB_TOP      3328
#define XB_TOPGEN   3392
#define XCD_BAR_WORDS 3456
#define XB_SPIN_CAP (1u << 18)

__device__ __forceinline__ unsigned xb_ld(unsigned* p)              { return __hip_atomic_load(p, __ATOMIC_RELAXED, __HIP_MEMORY_SCOPE_AGENT); }
__device__ __forceinline__ unsigned xb_add(unsigned* p, unsigned v) { return __hip_atomic_fetch_add(p, v, __ATOMIC_RELAXED, __HIP_MEMORY_SCOPE_AGENT); }
__device__ __forceinline__ unsigned xb_xcc_id() { return (unsigned)__builtin_amdgcn_s_getreg((3 << 11) | 20) & 0xFu; }
#define XB_SPIN(cond, bar) do { unsigned _sp = 0; while (cond) { __builtin_amdgcn_s_sleep(1); \
    if ((++_sp & 255u) == 0u) { if (xb_ld(&(bar)[XB_TMO])) break; if (_sp > XB_SPIN_CAP) { atomicAdd(&(bar)[XB_TMO], 1u); break; } } } } while (0)

struct XcdBarrier {
    unsigned* bar; unsigned x;
    volatile LAS unsigned* st;
};

__device__ __forceinline__ XcdBarrier xcd_barrier_post(unsigned* bar, volatile LAS unsigned* st) {
    XcdBarrier b; b.bar = bar; b.x = xb_xcc_id(); b.st = st;
    if (threadIdx.x == 0) (void)xb_add(&bar[XB_XCNT(b.x)], 1u);
    return b;
}
__device__ __forceinline__ void xcd_barrier_complete(unsigned* bar, unsigned x, unsigned& nloc, unsigned& nx) {
    const unsigned G = gridDim.x * gridDim.y * gridDim.z;
    unsigned sum, cnt, mine, sp = 0u;
    for (;;) {
        sum = 0u; cnt = 0u; mine = 0u;
#pragma unroll
        for (unsigned j = 0; j < 16; ++j) { const unsigned c = xb_ld(&bar[XB_XCNT(j)]); sum += c; cnt += (c > 0u) ? 1u : 0u; mine = (j == x) ? c : mine; }
        if (sum == G) break;
        __builtin_amdgcn_s_sleep(1);
        if ((++sp & 255u) == 0u) { if (xb_ld(&bar[XB_TMO])) break; if (sp > XB_SPIN_CAP) { atomicAdd(&bar[XB_TMO], 1u); break; } }
    }
    nloc = mine > 0u ? mine : 1u; nx = cnt > 0u ? cnt : 1u;
}

__device__ __forceinline__ void xcd_barrier(const XcdBarrier& b) {
    asm volatile("s_waitcnt vmcnt(0)" ::: "memory");
    __syncthreads();
    if (threadIdx.x == 0) {
        unsigned* bar = b.bar;
        __builtin_amdgcn_s_waitcnt(0);
        unsigned nloc = b.st[0], nx = b.st[1];
        if (nloc == 0u) { xcd_barrier_complete(bar, b.x, nloc, nx); b.st[0] = nloc; b.st[1] = nx; }
        const unsigned old = xb_add(&bar[XB_XSUB(b.x)], 1u);
        const unsigned gen = old / nloc;
        if (old + 1u == (gen + 1u) * nloc) {
            __builtin_amdgcn_fence(__ATOMIC_RELEASE, "agent");
            asm volatile("s_waitcnt vmcnt(0)" ::: "memory");
            const unsigned og = xb_add(&bar[XB_TOP], 1u);
            const unsigned tg = og / nx;
            if (og + 1u == (tg + 1u) * nx) xb_add(&bar[XB_TOPGEN], 1u);
            else XB_SPIN(xb_ld(&bar[XB_TOPGEN]) == tg, bar);
            __builtin_amdgcn_fence(__ATOMIC_ACQUIRE, "agent");
            xb_add(&bar[XB_XGEN(b.x)], 1u);
            asm volatile("s_waitcnt vmcnt(0)" ::: "memory");
        } else {
            XB_SPIN(xb_ld(&bar[XB_XGEN(b.x)]) == gen, bar);
            __builtin_amdgcn_fence(__ATOMIC_ACQUIRE, "agent");
            asm volatile("s_waitcnt vmcnt(0)" ::: "memory");
        }
    }
    __syncthreads();
}

__global__ void __launch_bounds__(NTHR, 2) fwd_megakernel(Args A_unused) {
    extern __shared__ __attribute__((aligned(16))) unsigned char lds_raw[];
    LAS unsigned char* lds = (LAS unsigned char*)lds_raw;
    cg::grid_group grid = cg::this_grid();
    const CArgs A0 = (CArgs)__builtin_amdgcn_kernarg_segment_ptr();
    const int G = gridDim.x, bx = blockIdx.x;
    volatile LAS unsigned* xst = (volatile LAS unsigned*)(lds + LDS_BYTES - 64);
    if (threadIdx.x < 2) xst[threadIdx.x] = 0u;
    __syncthreads();
    const XcdBarrier xbar = xcd_barrier_post((unsigned*)(A0->ws + WS_BAR), xst);
#define GRID_SYNC1() xcd_barrier(xbar)
#define GRID_SYNC_CG() do { asm volatile("s_waitcnt vmcnt(0) lgkmcnt(0)" ::: "memory"); grid.sync(); } while (0)
#if PROBE_SYNC2
#define GRID_SYNC() do { GRID_SYNC1(); GRID_SYNC1(); } while (0)
#else
#define GRID_SYNC() GRID_SYNC1()
#endif
#define GRID_SYNC_UNUSED() do { } while (0)
#define PHASE_BEGIN() CArgs A = A0; LAUNDER_S(A); int tid = threadIdx.x; LAUNDER_V(tid); const int lane = tid & 63, wave = __builtin_amdgcn_readfirstlane(tid >> 6); const int gw = bx * NWAVES + wave, NGW = G * NWAVES; \
    unsigned char* ws = A->ws; float* X = A->out + O_Y; float* SS = (float*)(ws + WS_SS); bf16* XB = (bf16*)(ws + WS_XB); (void)lane; (void)gw; (void)NGW; (void)X; (void)SS; (void)XB

    {
        PHASE_BEGIN();
        cvt_run(A, 2, 0, 0, 1, 0, 0, 0, 0, 0, lds, gw, NGW, wave, lane);
        for (int m0 = gw; m0 < M; m0 += 3 * NGW) {
            f32x4 v[3][4];
#pragma unroll
            for (int r = 0; r < 3; ++r) { const int m = m0 + r * NGW; if (m < M) { const float* src = (m < MP) ? (A->in[0] + (size_t)m * D) : (A->in[1] + (size_t)(m - MP) * D);
#pragma unroll
                for (int j = 0; j < 4; ++j) v[r][j] = *(const f32x4*)(src + (lane + 64 * j) * 4); } }
#pragma unroll
            for (int r = 0; r < 3; ++r) { const int m = m0 + r * NGW; if (m < M) { float s2 = 0.f;
#pragma unroll
                for (int j = 0; j < 4; ++j) { s2 += (v[r][j][0] * v[r][j][0] + v[r][j][1] * v[r][j][1]) + (v[r][j][2] * v[r][j][2] + v[r][j][3] * v[r][j][3]);
                    v2u o; o.x = pk2(v[r][j][0], v[r][j][1]); o.y = pk2(v[r][j][2], v[r][j][3]); *(v2u*)(XB + (size_t)m * D + (lane + 64 * j) * 4) = o; }
                s2 = wave_sum(s2);
                if (lane < 4) *(f32x4*)(SS + (size_t)m * 16 + lane * 4) = (f32x4){lane == 0 ? s2 : 0.f, 0.f, 0.f, 0.f}; } }
        }
    }
    GRID_SYNC_CG();

#pragma unroll 1
    for (int layer = 0; layer < 4; ++layer) {
        const int i2 = layer >> 1; const bool odd = layer & 1;
#pragma unroll 1
        for (int rep = 0; rep < 1 + PROBE_IN2; ++rep) {
        if (!odd) { PHASE_BEGIN(); pg8::Gemm g{XB, (const bf16*)(ws + WS_WIN), M, EVEN_IN, D}; pg8::StaticOrderT<6> S; S.init(D, G, bx);
            pg8::EpiAct<0> E{(bf16*)(ws + WS_Z), EVEN_IN, SS + (size_t)(2 * layer) * M * 16, (float*)(ws + WS_VST)};
            pg8::gemm_phase<pg8::EpiAct<0>, pg8::StaticOrderT<6>, true, true>(lds, g, S, E, tid); }
        else { PHASE_BEGIN(); pg8::Gemm g{XB, (const bf16*)(ws + WS_WIN), M, ODD_IN, D}; pg8::StaticOrderT<10> S; S.init(D, G, bx);
            pg8::EpiOdd E{(bf16*)(ws + WS_Z), SS + (size_t)(2 * layer) * M * 16};
            pg8::gemm_phase<pg8::EpiOdd, pg8::StaticOrderT<10>, true, true>(lds, g, S, E, tid); } }
        GRID_SYNC();
#pragma unroll 1
        for (int rep = 0; rep < 1 + PROBE_MIX2; ++rep) {
        { PHASE_BEGIN(); unsigned* rdy = (unsigned*)(ws + WS_RDY) + layer * 72; const int nu = M / 64;
          for (int k = 0; k < 2; ++k) { int q;
              if (G == 256) { if (k == 0) q = bx + 32; else { if (bx < 224) break; q = bx - 224; } }
              else { q = bx + k * G; if (k == 1) { for (int q2 = q; q2 < nu; q2 += G) { if (!odd) even_unit(A, i2, q2, lds, tid, wave, lane); else odd_unit(A, i2, q2, lds, tid, wave, lane);
                          asm volatile("s_waitcnt vmcnt(0)" ::: "memory"); __syncthreads(); if (tid == 0) __hip_atomic_fetch_add(rdy + (q2 >> 2), 1u, __ATOMIC_RELAXED, __HIP_MEMORY_SCOPE_AGENT); } break; } if (q >= nu) break; }
              if (!odd) even_unit(A, i2, q, lds, tid, wave, lane); else odd_unit(A, i2, q, lds, tid, wave, lane);
              asm volatile("s_waitcnt vmcnt(0)" ::: "memory"); __syncthreads();
              if (tid == 0) __hip_atomic_fetch_add(rdy + (q >> 2), 1u, __ATOMIC_RELAXED, __HIP_MEMORY_SCOPE_AGENT); } }
        __syncthreads(); }
#pragma unroll 1
        for (int rep = 0; rep < 1 + PROBE_CVT2; ++rep)
        { PHASE_BEGIN();
          const bool skew = (G == 256); const int cng = skew ? NGW - 32 * NWAVES : NGW;
          if ((!skew || bx < 224) && layer == 0) cvt_run(A, 1, 2, 0, 0, 0, 0, 0, 0, 0, lds, gw, cng, wave, lane); }
        if (G != 256) GRID_SYNC();
#pragma unroll 1
        for (int rep = 0; rep < 1 + PROBE_OUT2; ++rep)
        { PHASE_BEGIN(); pg8::Gemm g{(const bf16*)(ws + WS_MIX), (const bf16*)(ws + WS_WOUT + (size_t)(layer & 1) * 2 * MiB), M, D, D}; pg8::EpiRes E{X, ws, 2 * layer};
#if PROBE_OUT2 || PROBE_FF2X2
          E.dry = rep < PROBE_OUT2;
#endif

          if (G == 256) { pg8::Counted<pg8::TailOrder256> S; S.init(D, G, bx); S.ready = (const unsigned*)(ws + WS_RDY) + layer * 72; S.need = 4u;
              pg8::gemm_phase<pg8::EpiRes, pg8::Counted<pg8::TailOrder256>, true, true>(lds, g, S, E, tid); }
          else { pg8::StaticOrderT<4> S; S.init(D, G, bx); pg8::gemm_phase<pg8::EpiRes, pg8::StaticOrderT<4>, true, true>(lds, g, S, E, tid); } }
        { PHASE_BEGIN();
          if (G == 256 && bx >= 128) pg8::tail_job(X, ws, 2 * layer, (bx - 128) * NWAVES + wave, lane);
          const bool skew = (G == 256); const int cgw = skew ? gw - 128 * NWAVES : gw, cng = skew ? NGW - 128 * NWAVES : NGW;
          if (cgw >= 0) { if (layer < 3) cvt_run(A, 2, 3, layer, 0, layer + 1, 0, 0, 0, 0, lds, cgw, cng, wave, lane); else cvt_run(A, 1, 3, layer, 0, 0, 0, 0, 0, 0, lds, cgw, cng, wave, lane); } }
        GRID_SYNC();
#pragma unroll 1
        for (int rep = 0; rep < 1 + PROBE_FF1X2; ++rep)
        { PHASE_BEGIN(); pg8::Gemm g{XB, (const bf16*)(ws + WS_WFF1), M, FF, D}; pg8::StaticOrderT<16> S; S.init(D, G, bx);
          pg8::EpiAct<2> E{(bf16*)(ws + WS_H), FF, SS + (size_t)(2 * layer + 1) * M * 16, nullptr};
          pg8::gemm_phase<pg8::EpiAct<2>, pg8::StaticOrderT<16>, true, true>(lds, g, S, E, tid); }
        GRID_SYNC();
#pragma unroll 1
        for (int rep = 0; rep < 1 + PROBE_FF2X2; ++rep)
        { PHASE_BEGIN(); pg8::Gemm g{(const bf16*)(ws + WS_H), (const bf16*)(ws + WS_WFF2), M, D, FF}; pg8::EpiRes E{X, ws, 2 * layer + 1};
#if PROBE_OUT2 || PROBE_FF2X2
          E.dry = rep < PROBE_FF2X2;
#endif

          if (G == 256) { pg8::TailOrder256 S; S.init(FF, G, bx); pg8::gemm_phase<pg8::EpiRes, pg8::TailOrder256, true, true>(lds, g, S, E, tid); }
          else { pg8::StaticOrderT<4> S; S.init(FF, G, bx); pg8::gemm_phase<pg8::EpiRes, pg8::StaticOrderT<4>, true, true>(lds, g, S, E, tid); } }
        { PHASE_BEGIN(); if (G == 256 && bx >= 128) pg8::tail_job(X, ws, 2 * layer + 1, (bx - 128) * NWAVES + wave, lane); }
        if (layer < 3) { PHASE_BEGIN();
          const bool skew = (G == 256); const int cgw = skew ? gw - 128 * NWAVES : gw, cng = skew ? NGW - 128 * NWAVES : NGW;
          if (cgw >= 0) cvt_run(A, 2, 1, layer + 1, 2, layer + 1, 0, 0, 0, 0, lds, cgw, cng, wave, lane); }
        GRID_SYNC();
    }
    {
        PHASE_BEGIN();
        const float* fg = A->in[7]; const float* ss = SS + (size_t)8 * M * 16;
        f32x4 gv[4];
#pragma unroll
        for (int j = 0; j < 4; ++j) gv[j] = *(const f32x4*)(fg + (lane + 64 * j) * 4);
        const bf16* XL = (const bf16*)X;
        for (int m = gw; m < M; m += NGW) {
            const float spv = lane < 16 ? ss[(size_t)m * 16 + lane] : 0.f;
            v2u h[4], l[4];
#pragma unroll
            for (int j = 0; j < 4; ++j) { h[j] = *(const v2u*)(XB + (size_t)m * D + (lane + 64 * j) * 4); l[j] = *(const v2u*)(XL + (size_t)m * 2048 + 1024 + (lane + 64 * j) * 4); }
            const float rs = __builtin_amdgcn_rsqf(wave_sum(spv) * (1.0f / 1024.0f) + EPS);
            asm volatile("s_waitcnt vmcnt(0)" ::: "memory");
#pragma unroll
            for (int j = 0; j < 4; ++j) { const f32x4 x = (f32x4){bflo(h[j].x) + bflo(l[j].x), bfhi(h[j].x) + bfhi(l[j].x), bflo(h[j].y) + bflo(l[j].y), bfhi(h[j].y) + bfhi(l[j].y)};
                *(f32x4*)(X + (size_t)m * D + (lane + 64 * j) * 4) = x * rs * gv[j]; }
        }
    }
}

extern "C" void kernel_launch(void* const* d_in, const int* in_sizes, int n_in, void* d_out, int out_size, void* d_ws, size_t ws_size, hipStream_t stream) {
    static int grid = 0;
    if (grid == 0) {
        if (n_in != 25 || (size_t)out_size != O_END || ws_size < WS_END) { fprintf(stderr, "kernel_launch: unexpected shapes (n_in %d out %d ws %zu)\n", n_in, out_size, ws_size); grid = -1; return; }
        int dev = 0, cus = 0, per_cu = 0;
        (void)hipGetDevice(&dev); (void)hipDeviceGetAttribute(&cus, hipDeviceAttributeMultiprocessorCount, dev);
        (void)hipFuncSetAttribute((const void*)fwd_megakernel, hipFuncAttributeMaxDynamicSharedMemorySize, LDS_BYTES);
        (void)hipOccupancyMaxActiveBlocksPerMultiprocessor(&per_cu, (const void*)fwd_megakernel, NTHR, LDS_BYTES);
        (void)hipGetLastError();
        if (per_cu < 1) per_cu = 1;
        grid = cus * per_cu;
        fprintf(stderr, "kernel_launch: cus %d per_cu %d grid %d ws %zu\n", cus, per_cu, grid, ws_size);
    }
    if (grid < 0) return;
    (void)hipMemsetAsync((unsigned char*)d_ws + WS_CNT, 0, ZERO_BYTES, stream);
    Args a{};
    for (int i = 0; i < 25; ++i) a.in[i] = (const float*)d_in[i];
    a.out = (float*)d_out; a.ws = (unsigned char*)d_ws;
    void* args[] = {&a};
    hipError_t e = hipLaunchCooperativeKernel((const void*)fwd_megakernel, dim3(grid), dim3(NTHR), args, LDS_BYTES, stream);
    if (e != hipSuccess) fprintf(stderr, "cooperative launch failed: %s (grid %d)\n", hipGetErrorString(e), grid);
}
```

```cpp
#include <hip/hip_runtime.h>
#include <hip/hip_cooperative_groups.h>
#include <cstdio>
#include <cstdint>
#ifndef PROBE_SYNC2
#define PROBE_SYNC2 0
#define PROBE_MIX2 0
#define PROBE_CVT2 0
#define PROBE_FF1X2 0
#define PROBE_IN2 0
#define RES_LO 0
#define PROBE_OUT2 0
#define PROBE_FF2X2 0
#endif
namespace pg8 {
#define PG8_LAS __attribute__((address_space(3)))
typedef unsigned short bf16_t;
typedef short bf16x8 __attribute__((ext_vector_type(8)));
typedef float f32x4 __attribute__((ext_vector_type(4)));
typedef unsigned u32x4 __attribute__((ext_vector_type(4)));
constexpr int BM = 256, BK = 64, HALF = 128, HTB = HALF * BK * 2  , STAGE_BYTES = 8 * HTB, NXCD = 8, WGM = 8;

__host__ __device__ __forceinline__ int lds_byte(int r, int c) { const int st = (r >> 4) * 2 + (c >> 5), rr = r & 15, cc = c & 31, ob = rr * 64 + cc * 2; return st * 1024 + (ob ^ (((ob >> 9) & 1) << 5)); }
__host__ __device__ __forceinline__ void stage_rc(int b, int& R, int& C) { const int st = b / 1024, sb = b % 1024, swz = sb ^ (((sb >> 9) & 1) << 5); R = (st >> 1) * 16 + swz / 64; C = (st & 1) * 32 + (swz % 64) / 2; }
__host__ __device__ __forceinline__ int perm32(int rho) { const int n = rho >> 4, i = rho & 15; return 8 * (i >> 2) + 4 * n + (i & 3); }

struct Unit { int pm, pn, kt0, nkt, split; };
struct Gemm { const bf16_t* A; const bf16_t* Bt; int M, N, K; };

template <int NN> struct StaticOrderT {
    static constexpr int nM = 72, nN = NN, nwg = nM * nN, nkt_unused = 0;
    int G, c, nkt;
    __host__ __device__ void init(int K, int G_, int c_) { G = G_; c = c_; nkt = K / BK; }
    __host__ __device__ static void tile_of(int L, Unit& u) {
        static_assert(nwg % NXCD == 0 && nM % WGM == 0, "order constants");
        const int q = nwg / NXCD, xcd = L % NXCD, off = L / NXCD, wgid = xcd * q + off;
        const int nig = WGM * nN, gid = wgid / nig, fm = gid * WGM;
        u.pm = fm + ((wgid % nig) % WGM); u.pn = (wgid % nig) / WGM; }
    __host__ __device__ bool next(int i, Unit& u) const {
        const int L = i * G + c; if (L >= nwg) return false;
        tile_of(L, u); u.kt0 = 0; u.nkt = nkt; u.split = -1; return true;
    }
    __device__ __forceinline__ void a_ready(const Unit&) const {}
    __device__ __forceinline__ void done(const Unit&) const {}
};
constexpr int NS = 4;
struct TailOrder256 : StaticOrderT<4> {
    __host__ __device__ bool next(int i, Unit& u) const {
        const bool has_tail = c < 32 * NS, tail_now = has_tail && i == 0, full_now = has_tail ? (i == 1) : (i == 0);
        if (!(tail_now || full_now)) return false;
        tile_of(tail_now ? 256 + c / NS : c, u);
        u.nkt = tail_now ? nkt / NS : nkt; u.split = tail_now ? c % NS : -1; u.kt0 = tail_now ? (c % NS) * (nkt / NS) : 0;
        return true;
    }
};
template <class Base> struct Counted : Base {
    const unsigned* ready; unsigned need;
    __device__ __forceinline__ void a_ready(const Unit& u) const {
        if (threadIdx.x < 64) {
            unsigned spins = 0;
            while ((unsigned)__builtin_amdgcn_readfirstlane((int)__hip_atomic_load(ready + u.pm, __ATOMIC_RELAXED, __HIP_MEMORY_SCOPE_AGENT)) < need) { __builtin_amdgcn_s_sleep(2); if (++spins > (1u << 22)) break; }
            __builtin_amdgcn_fence(__ATOMIC_ACQUIRE, "agent");
            asm volatile("s_waitcnt vmcnt(0)" ::: "memory");
        }
        asm volatile("" ::: "memory"); __builtin_amdgcn_s_barrier(); asm volatile("" ::: "memory");
    }
};
__device__ __forceinline__ unsigned cvt_pk_bf16(float lo, float hi) { unsigned r; asm volatile("v_cvt_pk_bf16_f32 %0, %1, %2" : "=v"(r) : "v"(lo), "v"(hi)); return r; }
typedef float f32x2 __attribute__((ext_vector_type(2)));
constexpr float NORM_EPS = 1e-6f;
constexpr size_t EPI_WS_XB = (size_t)26 << 20, EPI_WS_SS = (size_t)206 << 20, EPI_WS_PART = (size_t)218 << 20, EPI_WS_CNT = (size_t)250 << 20;
typedef float f32x2e __attribute__((ext_vector_type(2)));
__device__ __forceinline__ float gelu_tanh(float v) {
    const float z = v * (1.0f + 0.044715f * v * v) * (-1.5957691216f * 1.4426950409f);
    return v * __builtin_amdgcn_rcpf(1.0f + __builtin_amdgcn_exp2f(z));
}
__device__ __forceinline__ float sigm(float g) { return __builtin_amdgcn_rcpf(1.0f + __builtin_amdgcn_exp2f(g * -1.4426950409f)); }
__device__ __forceinline__ float row_rstd(const float* ss, int row, int fq) {
    const f32x4 sp = *(const f32x4*)(ss + (size_t)row * 16 + fq * 4); float sr = (sp[0] + sp[1]) + (sp[2] + sp[3]); sr += __shfl_xor(sr, 16); sr += __shfl_xor(sr, 32);
    return __builtin_amdgcn_rsqf(sr * (1.0f / 1024.0f) + NORM_EPS);
}
__device__ __forceinline__ void row_rstd8(const float* ss, int row0, int fq, float (&rs)[2][4]) {
    f32x4 sp[2][4];
#pragma unroll
    for (int ai = 0; ai < 2; ++ai)
#pragma unroll
        for (int m = 0; m < 4; ++m) sp[ai][m] = *(const f32x4*)(ss + (size_t)(row0 + ai * HALF + m * 16) * 16 + fq * 4);
    asm volatile("" ::: "memory");
#pragma unroll
    for (int ai = 0; ai < 2; ++ai)
#pragma unroll
        for (int m = 0; m < 4; ++m) { float sr = (sp[ai][m][0] + sp[ai][m][1]) + (sp[ai][m][2] + sp[ai][m][3]); sr += __shfl_xor(sr, 16); sr += __shfl_xor(sr, 32);
            rs[ai][m] = __builtin_amdgcn_rsqf(sr * (1.0f / 1024.0f) + NORM_EPS); }
}
template <int MODE> struct EpiAct {
    static constexpr bool PERM = true, AFTER_DRAIN = false;
    bf16_t* O; int ldc; const float* ss; float* vst;
    __device__ __forceinline__ void operator()(f32x4 (&acc)[2][2][4][2], const Unit& u, int wr, int wc, int fr_, int fq_, int wid, int lane_) const {
        int fr = fr_, fq = fq_, lane = lane_; asm volatile("" : "+v"(fr), "+v"(fq), "+v"(lane));
        const int row0 = u.pm * BM + wr * 64 + fr, col0 = u.pn * BM + wc * 32 + 8 * fq;
        const bool act = (MODE == 0) && (u.pn < 4); const bool st = (MODE == 0) && (u.pn == 2 || u.pn == 3);
        float rsv[2][4]; row_rstd8(ss, row0, fq, rsv);
#pragma unroll
        for (int ai = 0; ai < 2; ++ai)
#pragma unroll
            for (int m = 0; m < 4; ++m) { const int row = row0 + ai * HALF + m * 16; const float rs = rsv[ai][m];
                bf16_t* rowp = O + (size_t)row * ldc + col0; float s1 = 0.f, s2 = 0.f;
#pragma unroll
                for (int bj = 0; bj < 2; ++bj) { f32x4 v0 = acc[ai][bj][m][0] * rs, v1 = acc[ai][bj][m][1] * rs;
                    if (MODE == 0) { if (act) {
#pragma unroll
                        for (int e = 0; e < 4; ++e) { v0[e] = gelu_tanh(v0[e]); v1[e] = gelu_tanh(v1[e]); } }
                        if (st) { s1 += (v0[0] + v0[1]) + (v0[2] + v0[3]) + (v1[0] + v1[1]) + (v1[2] + v1[3]);
                                  s2 += (v0[0] * v0[0] + v0[1] * v0[1]) + (v0[2] * v0[2] + v0[3] * v0[3]) + (v1[0] * v1[0] + v1[1] * v1[1]) + (v1[2] * v1[2] + v1[3] * v1[3]); } }
                    if (MODE == 2) {
#pragma unroll
                        for (int e = 0; e < 4; ++e) { const float a = fmaxf(v0[e], 0.f), b = fmaxf(v1[e], 0.f); v0[e] = a * a; v1[e] = b * b; } }
                    u32x4 w; w.x = cvt_pk_bf16(v0[0], v0[1]); w.y = cvt_pk_bf16(v0[2], v0[3]); w.z = cvt_pk_bf16(v1[0], v1[1]); w.w = cvt_pk_bf16(v1[2], v1[3]);
                    *(u32x4*)(rowp + bj * HALF) = w; }
                if (MODE == 0) { if (st) { s1 += __shfl_xor(s1, 16); s1 += __shfl_xor(s1, 32); s2 += __shfl_xor(s2, 16); s2 += __shfl_xor(s2, 32);
                    if (fq == 0) *(f32x2e*)(vst + (size_t)row * 16 + ((u.pn - 2) * 4 + wc) * 2) = (f32x2e){s1, s2}; } } }
    }
};
struct EpiOdd {
    static constexpr bool PERM = true, AFTER_DRAIN = false;
    bf16_t* O; const float* ss;
    __device__ __forceinline__ void operator()(f32x4 (&acc)[2][2][4][2], const Unit& u, int wr, int wc, int fr_, int fq_, int wid, int lane_) const {
        int fr = fr_, fq = fq_, lane = lane_; asm volatile("" : "+v"(fr), "+v"(fq), "+v"(lane));
        const int row0 = u.pm * BM + wr * 64 + fr, cin = wc * 32 + 8 * fq;
        const int mode = u.pn < 4 ? 0 : (u.pn < 8 ? 1 : 2);
        const int cbase = mode == 0 ? 128 * u.pn : (mode == 1 ? 1024 + 128 * (u.pn - 4) : 512 + 256 * (u.pn - 8));
        float rsv[2][4]; row_rstd8(ss, row0, fq, rsv);
#pragma unroll
        for (int ai = 0; ai < 2; ++ai)
#pragma unroll
            for (int m = 0; m < 4; ++m) { const int row = row0 + ai * HALF + m * 16; const float rs = rsv[ai][m];
                bf16_t* rowp = O + (size_t)row * 1536 + cbase + cin;
                f32x4 a0 = acc[ai][0][m][0] * rs, a1 = acc[ai][0][m][1] * rs, b0 = acc[ai][1][m][0] * rs, b1 = acc[ai][1][m][1] * rs;
                if (mode == 2) {
                    u32x4 w; w.x = cvt_pk_bf16(a0[0], a0[1]); w.y = cvt_pk_bf16(a0[2], a0[3]); w.z = cvt_pk_bf16(a1[0], a1[1]); w.w = cvt_pk_bf16(a1[2], a1[3]); *(u32x4*)rowp = w;
                    u32x4 x; x.x = cvt_pk_bf16(b0[0], b0[1]); x.y = cvt_pk_bf16(b0[2], b0[3]); x.z = cvt_pk_bf16(b1[0], b1[1]); x.w = cvt_pk_bf16(b1[2], b1[3]); *(u32x4*)(rowp + HALF) = x;
                } else {
                    if (mode == 0) {
#pragma unroll
                        for (int e = 0; e < 4; ++e) { b0[e] = sigm(b0[e]); b1[e] = sigm(b1[e]); } }
                    a0 = a0 * b0; a1 = a1 * b1;
                    u32x4 w; w.x = cvt_pk_bf16(a0[0], a0[1]); w.y = cvt_pk_bf16(a0[2], a0[3]); w.z = cvt_pk_bf16(a1[0], a1[1]); w.w = cvt_pk_bf16(a1[2], a1[3]); *(u32x4*)rowp = w;
                } }
    }
};
__device__ __forceinline__ float bfl(unsigned w) { return __uint_as_float(w << 16); }
__device__ __forceinline__ float bfh(unsigned w) { return __uint_as_float(w & 0xffff0000u); }
__device__ __forceinline__ void res_load(int use, const float* src, const bf16_t* hp, const bf16_t* lp, f32x4& x0, f32x4& x1) {
    if (use == 0) { x0 = *(const f32x4*)src; x1 = *(const f32x4*)(src + 4); }
#if RES_LO
    else { const u32x4 h = *(const u32x4*)hp, l = *(const u32x4*)lp;
        x0 = (f32x4){bfl(h.x) + bfl(l.x), bfh(h.x) + bfh(l.x), bfl(h.y) + bfl(l.y), bfh(h.y) + bfh(l.y)};
        x1 = (f32x4){bfl(h.z) + bfl(l.z), bfh(h.z) + bfh(l.z), bfl(h.w) + bfl(l.w), bfh(h.w) + bfh(l.w)}; }
#else
    else { const u32x4 h = *(const u32x4*)hp; x0 = (f32x4){bfl(h.x), bfh(h.x), bfl(h.y), bfh(h.y)}; x1 = (f32x4){bfl(h.z), bfh(h.z), bfl(h.w), bfh(h.w)}; }
#endif
}
__device__ __forceinline__ void res_store(bf16_t* hp, bf16_t* lp, const f32x4 x0, const f32x4 x1) {
    u32x4 h; h.x = cvt_pk_bf16(x0[0], x0[1]); h.y = cvt_pk_bf16(x0[2], x0[3]); h.z = cvt_pk_bf16(x1[0], x1[1]); h.w = cvt_pk_bf16(x1[2], x1[3]);
#if RES_LO
    u32x4 l; l.x = cvt_pk_bf16(x0[0] - bfl(h.x), x0[1] - bfh(h.x)); l.y = cvt_pk_bf16(x0[2] - bfl(h.y), x0[3] - bfh(h.y)); l.z = cvt_pk_bf16(x1[0] - bfl(h.z), x1[1] - bfh(h.z)); l.w = cvt_pk_bf16(x1[2] - bfl(h.w), x1[3] - bfh(h.w));
    *(u32x4*)hp = h; *(u32x4*)lp = l;
#else
    *(u32x4*)hp = h;
#endif
}
struct EpiRes {
    static constexpr bool PERM = true, AFTER_DRAIN = false;
    float* X; unsigned char* wsb; int use;
#if PROBE_OUT2 || PROBE_FF2X2
    int dry;
#endif
    __device__ __forceinline__ void operator()(f32x4 (&acc)[2][2][4][2], const Unit& u, int wr, int wc, int fr_, int fq_, int wid, int lane_) const {
        int fr = fr_, fq = fq_, lane = lane_; asm volatile("" : "+v"(fr), "+v"(fq), "+v"(lane));
#if PROBE_OUT2 || PROBE_FF2X2
        if (dry) return;
#endif
        if (u.split >= 0) {
            typedef unsigned long long u64;
            const int s = u.split, tt = (int)blockIdx.x / NS; float* part = (float*)(wsb + EPI_WS_PART); unsigned* cnt = (unsigned*)(wsb + EPI_WS_CNT) + use * 256 + tt * 8 + wid;
            u64* P = (u64*)(part + (((size_t)tt * NS + s) * 8 + wid) * 8192) + lane * 2;
#pragma unroll
            for (int q = 0; q < 4; ++q)
#pragma unroll
                for (int mm = 0; mm < 2; ++mm)
#pragma unroll
                    for (int bj = 0; bj < 2; ++bj)
#pragma unroll
                        for (int n = 0; n < 2; ++n) { const f32x4 v = acc[q >> 1][bj][2 * (q & 1) + mm][n]; u64* p = P + (q * 8 + (mm * 2 + bj) * 2 + n) * 128;
                            __hip_atomic_store(p, ((u64)__float_as_uint(v[1]) << 32) | __float_as_uint(v[0]), __ATOMIC_RELAXED, __HIP_MEMORY_SCOPE_AGENT);
                            __hip_atomic_store(p + 1, ((u64)__float_as_uint(v[3]) << 32) | __float_as_uint(v[2]), __ATOMIC_RELAXED, __HIP_MEMORY_SCOPE_AGENT); }
            asm volatile("s_waitcnt vmcnt(0)" ::: "memory");
            if (lane == 0) (void)__hip_atomic_fetch_add(cnt, 1u, __ATOMIC_RELAXED, __HIP_MEMORY_SCOPE_AGENT);
            return;
        }
        const int row0 = u.pm * BM + wr * 64 + fr, col0 = u.pn * BM + wc * 32 + 8 * fq;
        bf16_t* XB = (bf16_t*)(wsb + EPI_WS_XB); float* ssout = (float*)(wsb + EPI_WS_SS) + (size_t)(use + 1) * (18432 * 16);
        const float* xsrc = X - (u.pm < 64 ? 0 : (size_t)16384 * 1024) * 0;
        if (use == 0) { typedef const float* const __attribute__((address_space(4)))* KP; const KP ka = (KP)__builtin_amdgcn_kernarg_segment_ptr(); xsrc = (u.pm < 64) ? ka[0] : ka[1] - (size_t)16384 * 1024; }
#pragma unroll
        for (int ai = 0; ai < 2; ++ai)
#pragma unroll
            for (int m = 0; m < 4; ++m) { const int row = row0 + ai * HALF + m * 16; float sq = 0.f;
                bf16_t* bp = XB + (size_t)row * 1024 + col0; bf16_t* lp = (bf16_t*)X + (size_t)row * 2048 + 1024 + col0;
                const float* sp_ = xsrc + (size_t)row * 1024 + col0;
#pragma unroll
                for (int bj = 0; bj < 2; ++bj) { f32x4 x0, x1; res_load(use, sp_ + bj * HALF, bp + bj * HALF, lp + bj * HALF, x0, x1);
                    x0 += acc[ai][bj][m][0]; x1 += acc[ai][bj][m][1];
                    sq += (x0[0] * x0[0] + x0[1] * x0[1]) + (x0[2] * x0[2] + x0[3] * x0[3]) + (x1[0] * x1[0] + x1[1] * x1[1]) + (x1[2] * x1[2] + x1[3] * x1[3]);
                    res_store(bp + bj * HALF, lp + bj * HALF, x0, x1); }
                sq += __shfl_xor(sq, 16); sq += __shfl_xor(sq, 32);
                if (fq == 0) ssout[(size_t)row * 16 + u.pn * 4 + wc] = sq;
                if (m == 3) asm volatile("" ::: "memory"); }
    }
};
__device__ __forceinline__ void tail_job(float* X, unsigned char* wsb, int use, int job, int lane) {
    typedef unsigned long long u64;
    const int tt = job >> 5, w = (job >> 2) & 7, s = job & 3, wr = w >> 2, wc = w & 3, fr = lane & 15, fq = lane >> 4;
    float* part = (float*)(wsb + EPI_WS_PART); unsigned* cnt = (unsigned*)(wsb + EPI_WS_CNT) + use * 256 + tt * 8 + w;
    { unsigned spins = 0;
      while ((unsigned)__builtin_amdgcn_readfirstlane((int)__hip_atomic_load(cnt, __ATOMIC_RELAXED, __HIP_MEMORY_SCOPE_AGENT)) < (unsigned)NS) { __builtin_amdgcn_s_sleep(2); if (++spins > (1u << 22)) break; } }
    f32x4 v[2][2][2];
#pragma unroll
    for (int mm = 0; mm < 2; ++mm)
#pragma unroll
        for (int bj = 0; bj < 2; ++bj)
#pragma unroll
            for (int n = 0; n < 2; ++n) { f32x4 sum = (f32x4){0.f, 0.f, 0.f, 0.f};
#pragma unroll
                for (int sp = 0; sp < NS; ++sp) { const u64* qp = (const u64*)(part + (((size_t)tt * NS + sp) * 8 + w) * 8192) + lane * 2 + (s * 8 + (mm * 2 + bj) * 2 + n) * 128;
                    const u64 lo = __hip_atomic_load(qp, __ATOMIC_RELAXED, __HIP_MEMORY_SCOPE_AGENT), hi = __hip_atomic_load(qp + 1, __ATOMIC_RELAXED, __HIP_MEMORY_SCOPE_AGENT);
                    sum += (f32x4){__uint_as_float((unsigned)lo), __uint_as_float((unsigned)(lo >> 32)), __uint_as_float((unsigned)hi), __uint_as_float((unsigned)(hi >> 32))}; }
                v[mm][bj][n] = sum; }
    Unit u; StaticOrderT<4>::tile_of(256 + tt, u);
    const int ai = s >> 1, row0 = u.pm * BM + ai * HALF + wr * 64 + fr, col0 = u.pn * BM + wc * 32 + 8 * fq;
    bf16_t* XB = (bf16_t*)(wsb + EPI_WS_XB); float* ssout = (float*)(wsb + EPI_WS_SS) + (size_t)(use + 1) * (18432 * 16);
    const float* xsrc = X;
    if (use == 0) { typedef const float* const __attribute__((address_space(4)))* KP; const KP ka = (KP)__builtin_amdgcn_kernarg_segment_ptr(); xsrc = (u.pm < 64) ? ka[0] : ka[1] - (size_t)16384 * 1024; }
#pragma unroll
    for (int mm = 0; mm < 2; ++mm) { const int row = row0 + (2 * (s & 1) + mm) * 16; float sq = 0.f;
        bf16_t* bp = XB + (size_t)row * 1024 + col0; bf16_t* lp = (bf16_t*)X + (size_t)row * 2048 + 1024 + col0; const float* sp_ = xsrc + (size_t)row * 1024 + col0;
#pragma unroll
        for (int bj = 0; bj < 2; ++bj) { f32x4 x0, x1; res_load(use, sp_ + bj * HALF, bp + bj * HALF, lp + bj * HALF, x0, x1);
            x0 += v[mm][bj][0]; x1 += v[mm][bj][1];
            sq += (x0[0] * x0[0] + x0[1] * x0[1]) + (x0[2] * x0[2] + x0[3] * x0[3]) + (x1[0] * x1[0] + x1[1] * x1[1]) + (x1[2] * x1[2] + x1[3] * x1[3]);
            res_store(bp + bj * HALF, lp + bj * HALF, x0, x1); }
        sq += __shfl_xor(sq, 16); sq += __shfl_xor(sq, 32);
        if (fq == 0) ssout[(size_t)row * 16 + u.pn * 4 + wc] = sq; }
}

template <class Epi, class Sched, bool ALIGN_EPI = false, bool SP2 = false>
__device__ __forceinline__ void gemm_phase(PG8_LAS unsigned char* lds, const Gemm g, const Sched& S, const Epi& E, const int tid_in) {
    const int tid = tid_in, wid = __builtin_amdgcn_readfirstlane(tid >> 6), lane = tid & 63, wr = wid >> 2, wc = wid & 3, fr = lane & 15, fq = lane >> 4;
    const int K = g.K;
    unsigned voffA[2], voffB[2];
#pragma unroll
    for (int i = 0; i < 2; ++i) { int R, C; stage_rc(tid * 16 + i * 8192, R, C); const int Rb = Epi::PERM ? ((R & ~31) + perm32(R & 31)) : R;
        voffA[i] = (unsigned)(R * K + C) * 2u; voffB[i] = (unsigned)(Rb * K + C) * 2u; }
    const size_t kstep = (size_t)(BK * 2);
    const size_t hstep = (size_t)HALF * K * 2;
    const size_t tstep = 2 * hstep;
    const unsigned ldsw = (unsigned)wid * 1024u;
    const int aoff = lds_byte(wr * 64 + fr, fq * 8), boff = lds_byte(wc * 32 + fr, fq * 8);
#define PG8_SA(b, h) (((b) * 2 + (h)) * HTB)
#define PG8_SB(b, h) ((4 + (b) * 2 + (h)) * HTB)
#define PG8_STAGE(bufoff, gbase, voff) do { _Pragma("unroll") for (int _i = 0; _i < 2; ++_i) \
        __builtin_amdgcn_global_load_lds((const unsigned*)((const char*)(gbase) + (voff)[_i]), (PG8_LAS unsigned*)(lds + (bufoff) + ldsw + _i * 8192), 16, 0, 0); } while (0)
#define PG8_LDA(dst, b, h) do { _Pragma("unroll") for (int m = 0; m < 4; ++m) _Pragma("unroll") for (int k = 0; k < 2; ++k) dst[m][k] = *(const PG8_LAS bf16x8*)(lds + PG8_SA(b, h) + aoff + m * 2048 + k * 1024); } while (0)
#define PG8_LDB(dst, b, h) do { _Pragma("unroll") for (int n = 0; n < 2; ++n) _Pragma("unroll") for (int k = 0; k < 2; ++k) dst[n][k] = *(const PG8_LAS bf16x8*)(lds + PG8_SB(b, h) + boff + n * 2048 + k * 1024); } while (0)
#define PG8_MMA(ai, bj, At, Bt) do { __builtin_amdgcn_s_setprio(1); _Pragma("unroll") for (int m = 0; m < 4; ++m) _Pragma("unroll") for (int n = 0; n < 2; ++n) _Pragma("unroll") for (int k = 0; k < 2; ++k) \
        acc[ai][bj][m][n] = __builtin_amdgcn_mfma_f32_16x16x32_bf16(Bt[n][k], At[m][k], acc[ai][bj][m][n], 0, 0, 0); __builtin_amdgcn_s_setprio(0); } while (0)
#define PG8_WAIT_V(n) asm volatile("s_waitcnt vmcnt(" #n ")" ::: "memory")
#define PG8_WAIT_L(n) asm volatile("s_waitcnt lgkmcnt(" #n ")" ::: "memory")
#define PG8_BAR __builtin_amdgcn_s_barrier()
#define PG8_SCHED __builtin_amdgcn_sched_barrier(0)
    Unit cur, nxt; int ui = 0;
    if (!S.next(0, cur)) return;
    f32x4 acc[2][2][4][2];
#pragma unroll
    for (int a = 0; a < 2; ++a)
#pragma unroll
        for (int b = 0; b < 2; ++b)
#pragma unroll
            for (int m = 0; m < 4; ++m)
#pragma unroll
                for (int n = 0; n < 2; ++n) acc[a][b][m][n] = (f32x4){0.f, 0.f, 0.f, 0.f};
    bf16x8 At[4][2], B0[2][2], B1[2][2];
    const char* cA = (const char*)g.A + (size_t)cur.pm * tstep + (size_t)cur.kt0 * kstep; const char* cB = (const char*)g.Bt + (size_t)cur.pn * tstep + (size_t)cur.kt0 * kstep;
    S.a_ready(cur);
    if constexpr (SP2) {
        PG8_STAGE(PG8_SB(0, 0), cB, voffB); PG8_STAGE(PG8_SB(0, 1), cB + hstep, voffB); PG8_STAGE(PG8_SA(0, 0), cA, voffA); PG8_STAGE(PG8_SA(0, 1), cA + hstep, voffA);
        if (wr == 1) PG8_BAR;
        PG8_WAIT_V(2); PG8_BAR;
        PG8_STAGE(PG8_SB(1, 0), cB + kstep, voffB); PG8_STAGE(PG8_SA(1, 0), cA + kstep, voffA); PG8_STAGE(PG8_SB(1, 1), cB + hstep + kstep, voffB);
        PG8_WAIT_V(6); PG8_BAR;
    } else {
        PG8_STAGE(PG8_SB(0, 0), cB, voffB); PG8_STAGE(PG8_SA(0, 0), cA, voffA); PG8_STAGE(PG8_SB(0, 1), cB + hstep, voffB); PG8_STAGE(PG8_SA(0, 1), cA + hstep, voffA);
        if (wr == 1) PG8_BAR;
        PG8_WAIT_V(4); PG8_BAR;
        PG8_STAGE(PG8_SB(1, 0), cB + kstep, voffB); PG8_STAGE(PG8_SA(1, 0), cA + kstep, voffA); PG8_STAGE(PG8_SB(1, 1), cB + hstep + kstep, voffB);
        PG8_WAIT_V(6); PG8_BAR;
    }
    for (;;) {
        const bool has_next = S.next(ui + 1, nxt);
        const char* nA = has_next ? (const char*)g.A + (size_t)nxt.pm * tstep + (size_t)nxt.kt0 * kstep : cA; const char* nB = has_next ? (const char*)g.Bt + (size_t)nxt.pn * tstep + (size_t)nxt.kt0 * kstep : cB;
        const int nt = cur.nkt;
        for (int t = 0; t < nt; t += 2) {
            const bool last = (t == nt - 2);
            const char* a1 = cA + (size_t)(t + 1) * kstep;
            const char* a2 = last ? nA : cA + (size_t)(t + 2) * kstep; const char* b2 = last ? nB : cB + (size_t)(t + 2) * kstep;
            const char* a3 = a2 + kstep; const char* b3 = b2 + kstep;
            if (last && has_next) S.a_ready(nxt);
            if constexpr (SP2) {
            PG8_LDB(B0, 0, 0); PG8_LDB(B1, 0, 1); PG8_SCHED; PG8_LDA(At, 0, 0); PG8_STAGE(PG8_SA(1, 1), a1 + hstep, voffA);
            PG8_WAIT_V(8); PG8_WAIT_L(0); PG8_BAR; PG8_MMA(0, 0, At, B0); PG8_MMA(0, 1, At, B1); PG8_BAR; PG8_SCHED;
            PG8_LDA(At, 0, 1); PG8_STAGE(PG8_SB(0, 0), b2, voffB); PG8_STAGE(PG8_SB(0, 1), b2 + hstep, voffB); PG8_STAGE(PG8_SA(0, 0), a2, voffA);
            PG8_WAIT_V(8); PG8_WAIT_L(0); PG8_BAR; PG8_MMA(1, 0, At, B0); PG8_MMA(1, 1, At, B1); PG8_BAR; PG8_SCHED;
            PG8_LDB(B0, 1, 0); PG8_LDB(B1, 1, 1); PG8_SCHED; PG8_LDA(At, 1, 0); PG8_STAGE(PG8_SA(0, 1), a2 + hstep, voffA);
            PG8_WAIT_V(8); PG8_WAIT_L(0); PG8_BAR; PG8_MMA(0, 0, At, B0); PG8_MMA(0, 1, At, B1); PG8_BAR; PG8_SCHED;
            PG8_LDA(At, 1, 1); PG8_STAGE(PG8_SB(1, 0), b3, voffB); PG8_STAGE(PG8_SB(1, 1), b3 + hstep, voffB); PG8_STAGE(PG8_SA(1, 0), a3, voffA);
            PG8_WAIT_V(8); PG8_WAIT_L(0); PG8_BAR; PG8_MMA(1, 0, At, B0); PG8_MMA(1, 1, At, B1); PG8_BAR; PG8_SCHED;
            } else {
            PG8_LDB(B0, 0, 0); PG8_SCHED; PG8_LDA(At, 0, 0); PG8_STAGE(PG8_SA(1, 1), a1 + hstep, voffA);
            PG8_WAIT_L(8); PG8_BAR; PG8_WAIT_L(0); PG8_MMA(0, 0, At, B0); PG8_BAR; PG8_SCHED;
            PG8_LDB(B1, 0, 1); PG8_STAGE(PG8_SB(0, 0), b2, voffB);
            PG8_BAR; PG8_WAIT_L(0); PG8_MMA(0, 1, At, B1); PG8_BAR;
            PG8_LDA(At, 0, 1); PG8_STAGE(PG8_SA(0, 0), a2, voffA);
            PG8_BAR; PG8_WAIT_L(0); PG8_MMA(1, 0, At, B0); PG8_BAR; PG8_SCHED;
            PG8_STAGE(PG8_SB(0, 1), b2 + hstep, voffB);
            PG8_WAIT_V(6); PG8_BAR; PG8_MMA(1, 1, At, B1); PG8_BAR;
            PG8_LDB(B0, 1, 0); PG8_SCHED; PG8_LDA(At, 1, 0); PG8_STAGE(PG8_SA(0, 1), a2 + hstep, voffA);
            PG8_WAIT_L(8); PG8_BAR; PG8_WAIT_L(0); PG8_MMA(0, 0, At, B0); PG8_BAR; PG8_SCHED;
            PG8_LDB(B1, 1, 1); PG8_STAGE(PG8_SB(1, 0), b3, voffB);
            PG8_BAR; PG8_WAIT_L(0); PG8_MMA(0, 1, At, B1); PG8_BAR;
            PG8_LDA(At, 1, 1); PG8_STAGE(PG8_SA(1, 0), a3, voffA);
            PG8_BAR; PG8_WAIT_L(0); PG8_MMA(1, 0, At, B0); PG8_BAR; PG8_SCHED;
            PG8_STAGE(PG8_SB(1, 1), b3 + hstep, voffB);
            PG8_WAIT_V(6); PG8_BAR; PG8_MMA(1, 1, At, B1); PG8_BAR;
            }
        }
        if constexpr (ALIGN_EPI) { if (wr == 0) PG8_BAR; }
        if constexpr (!Epi::AFTER_DRAIN) { E(acc, cur, wr, wc, fr, fq, wid, lane); S.done(cur); }
        if (!has_next) break;
#pragma unroll
        for (int a = 0; a < 2; ++a)
#pragma unroll
            for (int b = 0; b < 2; ++b)
#pragma unroll
                for (int m = 0; m < 4; ++m)
#pragma unroll
                    for (int n = 0; n < 2; ++n) acc[a][b][m][n] = (f32x4){0.f, 0.f, 0.f, 0.f};
        cur = nxt; cA = nA; cB = nB; ++ui;
        if constexpr (ALIGN_EPI) { if (wr == 1) PG8_BAR; }
    }
    PG8_WAIT_V(0);
    if constexpr (!ALIGN_EPI) { if (wr == 0) PG8_BAR; }
    PG8_BAR;
    if constexpr (Epi::AFTER_DRAIN) { E.fused(acc, cur, wr, wc, fr, fq, lds, wid, lane); S.done(cur); }
#undef PG8_SA
#undef PG8_SB
#undef PG8_STAGE
#undef PG8_LDA
#undef PG8_LDB
#undef PG8_MMA
#undef PG8_WAIT_V
#undef PG8_WAIT_L
#undef PG8_BAR
#undef PG8_SCHED
}
}

namespace cg = cooperative_groups;
#define GAS __attribute__((address_space(1)))
#define LAS __attribute__((address_space(3)))
typedef unsigned short bf16;
typedef unsigned v4u __attribute__((ext_vector_type(4)));
typedef unsigned v2u __attribute__((ext_vector_type(2)));
typedef float f32x4 __attribute__((ext_vector_type(4)));
typedef float f32x2 __attribute__((ext_vector_type(2)));
typedef short bf16x8 __attribute__((ext_vector_type(8)));

constexpr int NWAVES = 8, NTHR = 512;
constexpr int D = 1024, MP = 16384, MS = 2048, M = MP + MS, FF = 4096, EVEN_IN = 1536, ODD_IN = 2560, SEQ = 8192;
constexpr float EPS = 1e-6f;
constexpr int LDS_BYTES = 147456;
constexpr size_t MiB = 1u << 20;
constexpr size_t WS_SS = 206 * MiB;
constexpr size_t WS_WIN = 1 * MiB;
constexpr size_t WS_WOUT = 6 * MiB;
constexpr size_t WS_WFF1 = 10 * MiB;
constexpr size_t WS_WFF2 = 18 * MiB;
constexpr size_t WS_XB = 26 * MiB;
constexpr size_t WS_H = 62 * MiB;
constexpr size_t WS_Z = WS_H;
constexpr size_t WS_MIX = 152 * MiB;
constexpr size_t WS_PART = 218 * MiB;
constexpr size_t WS_CNT = 250 * MiB;
constexpr size_t CNT_BYTES = 8 * 256 * 4;
constexpr size_t WS_BAR = WS_CNT + CNT_BYTES;
constexpr size_t WS_RDY = WS_CNT + 22528;
constexpr size_t ZERO_BYTES = 24576;
static_assert(WS_BAR + 3456 * 4 <= WS_RDY && WS_RDY + 4 * 72 * 4 <= WS_CNT + ZERO_BYTES, "control words inside the memset region");
constexpr size_t WS_VST = 251 * MiB;
constexpr size_t WS_END = 253 * MiB;
static_assert(pg8::NS == 4, "partial buffer sized for 4 slices");
static_assert(pg8::EPI_WS_XB == WS_XB && pg8::EPI_WS_SS == WS_SS && pg8::EPI_WS_PART == WS_PART && pg8::EPI_WS_CNT == WS_CNT, "epilogue view of the d_ws map");
constexpr size_t O_Y = 0, O_POOL_P = (size_t)M * D, O_CC_P = O_POOL_P + 2 * 2 * 15 * 512, O_CD_P = O_CC_P + 2 * 2 * 30 * 512, O_AV_S = O_CD_P + 2 * 2 * 2 * 512,
                 O_POOL_S = O_AV_S + (size_t)2 * 32 * 64 * 512, O_CC_S = O_POOL_S + 2 * 32 * 15 * 512, O_CD_S = O_CC_S + 2 * 32 * 30 * 512, O_END = O_CD_S + 2 * 32 * 2 * 512;
static_assert(O_END == 22607872, "output size");

__device__ __forceinline__ float wave_sum(float v) {
#pragma unroll
    for (int o = 1; o < 64; o <<= 1) v += __shfl_xor(v, o);
    return v;
}
__device__ __forceinline__ unsigned pk2(float lo, float hi) { return pg8::cvt_pk_bf16(lo, hi); }
__device__ __forceinline__ float bflo(unsigned w) { return __uint_as_float(w << 16); }
__device__ __forceinline__ float bfhi(unsigned w) { return __uint_as_float(w & 0xffff0000u); }
__device__ __forceinline__ void unpack8(const v4u w, f32x4& a, f32x4& b) { a = (f32x4){bflo(w.x), bfhi(w.x), bflo(w.y), bfhi(w.y)}; b = (f32x4){bflo(w.z), bfhi(w.z), bflo(w.w), bfhi(w.w)}; }
__device__ __forceinline__ v4u pack8(const f32x4 a, const f32x4 b) { v4u w; w.x = pk2(a[0], a[1]); w.y = pk2(a[2], a[3]); w.z = pk2(b[0], b[1]); w.w = pk2(b[2], b[3]); return w; }
__device__ __forceinline__ void st_wt16(bf16* p, const v4u v) { asm volatile("global_store_dwordx4 %0, %1, off sc1" :: "v"(p), "v"(v) : "memory"); }
__device__ __forceinline__ void st_wt8(bf16* p, const v2u v) { asm volatile("global_store_dwordx2 %0, %1, off sc1" :: "v"(p), "v"(v) : "memory"); }
__device__ __forceinline__ float sigmoidf_(float g) { return __builtin_amdgcn_rcpf(1.0f + __builtin_amdgcn_exp2f(g * -1.4426950409f)); }

__device__ __forceinline__ int odd_src_col(int n0) { const int p = n0 >> 8, hf = (n0 >> 7) & 1, j = n0 & 127; return p < 4 ? hf * 512 + 128 * p + j : (p < 8 ? 1536 + hf * 512 + 128 * (p - 4) + j : 1024 + (n0 - 2048)); }
__device__ __forceinline__ void cvt_item(const float* W, int K, int N, const float* gk, bf16* WT, LAS float* scr, int item, int lane, bool remap = false) {
    const int nblk = N / 32, kb = item / nblk, nb = item % nblk, k0 = 64 * kb, n0 = 32 * nb, s0 = remap ? odd_src_col(n0) : n0;
#pragma unroll 1
    for (int hb = 0; hb < 2; ++hb) {
        float wv[16]; const float* wp = W + (size_t)(k0 + 32 * hb + (lane >> 5)) * N + s0 + (lane & 31);
#pragma unroll
        for (int i = 0; i < 16; ++i) wv[i] = wp[(size_t)(2 * i) * N];
#pragma unroll
        for (int i = 0; i < 16; ++i) { const int kk = 32 * hb + 2 * i + (lane >> 5); float w = wv[i]; if (gk) w *= gk[k0 + kk]; scr[kk * 33 + (lane & 31)] = w; }
    }
    asm volatile("s_waitcnt lgkmcnt(0)" ::: "memory");
    const int c = lane & 7;
#pragma unroll
    for (int j = 0; j < 4; ++j) { const int n = (lane >> 3) + 8 * j; const LAS float* s = scr + (8 * c) * 33 + n;
        v4u o; o.x = pk2(s[0 * 33], s[1 * 33]); o.y = pk2(s[2 * 33], s[3 * 33]); o.z = pk2(s[4 * 33], s[5 * 33]); o.w = pk2(s[6 * 33], s[7 * 33]);
        *(v4u*)(WT + (size_t)(n0 + n) * K + k0 + 8 * c) = o; }
    asm volatile("s_waitcnt lgkmcnt(0)" ::: "memory");
}
__device__ __forceinline__ void fold_item(const float* Wo, const float* pw, const float* bs, bf16* WT, LAS float* scr, int item, int lane) {
    const int nb = item & 31, ch = (item >> 5) & 1, g = item >> 6, n0 = nb * 32, c = ch * 64 + lane;
    { const int n = lane & 31, dh = lane >> 5; const float* wp = Wo + (size_t)(512 + g * 128 + dh) * 1024 + n0 + n; const float* sp = bs + g * 128 + dh;
#pragma unroll 1
      for (int b = 0; b < 4; ++b) { float wv[16], sv[16];
#pragma unroll
          for (int i = 0; i < 16; ++i) { wv[i] = wp[(size_t)(2 * (b * 16 + i)) * 1024]; sv[i] = sp[2 * (b * 16 + i)]; }
#pragma unroll
          for (int i = 0; i < 16; ++i) scr[(2 * (b * 16 + i) + dh) * 32 + n] = wv[i] * sv[i]; } }
    asm volatile("s_waitcnt lgkmcnt(0)" ::: "memory");
    f32x4 acc[8];
#pragma unroll
    for (int i = 0; i < 8; ++i) acc[i] = (f32x4){0.f, 0.f, 0.f, 0.f};
    const float* pr = pw + ((size_t)g * 128 + c) * 128;
#pragma unroll 1
    for (int d0 = 0; d0 < 128; d0 += 32) { f32x4 pv[8];
#pragma unroll
        for (int j = 0; j < 8; ++j) pv[j] = *(const f32x4*)(pr + d0 + 4 * j);
#pragma unroll
        for (int j = 0; j < 8; ++j)
#pragma unroll
            for (int dd = 0; dd < 4; ++dd)
#pragma unroll
                for (int n4 = 0; n4 < 8; ++n4) { const f32x4 w = *(const LAS f32x4*)(scr + (d0 + 4 * j + dd) * 32 + n4 * 4); acc[n4] += w * pv[j][dd]; } }
#pragma unroll
    for (int n4 = 0; n4 < 8; ++n4)
#pragma unroll
        for (int e = 0; e < 4; ++e) WT[(size_t)(n0 + n4 * 4 + e) * 1024 + 512 + g * 128 + c] = (bf16)(pk2(acc[n4][e], 0.f) & 0xffffu);
    asm volatile("s_waitcnt lgkmcnt(0)" ::: "memory");
}

struct Args { const float* in[25]; float* out; unsigned char* ws; };
typedef const __attribute__((address_space(4))) Args* CArgs;
#define LAUNDER_V(x) asm volatile("" : "+v"(x))
#define LAUNDER_S(x) asm volatile("" : "+s"(x))

__device__ __forceinline__ int cvt_count(int kind, int layer) {
    if (kind == 0) return (layer & 1) ? 16 * (ODD_IN / 32) : 16 * (EVEN_IN / 32);
    if (kind == 1) return (layer & 1) ? 16 * 32 : 8 * 32 + 256;
    if (kind == 2) return 16 * (FF / 32);
    return (FF / 64) * 32;
}
__device__ __forceinline__ void cvt_do(CArgs A, int kind, int layer, int item, LAS float* scr, int lane) {
    unsigned char* ws = A->ws; const int i = layer >> 1;
    if (kind == 0) {
        if (layer & 1) cvt_item(A->in[16] + (size_t)i * D * ODD_IN, D, ODD_IN, A->in[5] + layer * D, (bf16*)(ws + WS_WIN), scr, item, lane, true);
        else cvt_item(A->in[8] + (size_t)i * D * EVEN_IN, D, EVEN_IN, A->in[5] + layer * D, (bf16*)(ws + WS_WIN), scr, item, lane);
    } else if (kind == 1) {
        bf16* wt = (bf16*)(ws + WS_WOUT + (size_t)(layer & 1) * 2 * MiB);
        if (layer & 1) cvt_item(A->in[17] + (size_t)i * D * D, D, D, nullptr, wt, scr, item, lane);
        else { if (item < 256) cvt_item(A->in[9] + (size_t)i * D * D, D, D, nullptr, wt, scr, item, lane);
               else fold_item(A->in[9] + (size_t)i * D * D, A->in[14] + (size_t)i * 4 * 128 * 128, A->in[15] + i * 512, wt, scr, item - 256, lane); }
    } else if (kind == 2) cvt_item(A->in[23] + (size_t)layer * D * FF, D, FF, A->in[6] + layer * D, (bf16*)(ws + WS_WFF1), scr, item, lane);
    else cvt_item(A->in[24] + (size_t)layer * FF * D, FF, D, nullptr, (bf16*)(ws + WS_WFF2), scr, item, lane);
}
__device__ __forceinline__ void cvt_run(CArgs A, int nk, int k0, int l0, int k1, int l1, int k2, int l2, int k3, int l3, LAS unsigned char* lds, int gw, int NGW, int wave, int lane) {
    LAS float* scr = (LAS float*)(lds + wave * 16384);
    const int c0 = cvt_count(k0, l0), c1 = nk > 1 ? cvt_count(k1, l1) : 0, c2 = nk > 2 ? cvt_count(k2, l2) : 0, c3 = nk > 3 ? cvt_count(k3, l3) : 0;
    const int tot = c0 + c1 + c2 + c3;
    for (int it = gw; it < tot; it += NGW) {
        int r = it;
        if (r < c0) { cvt_do(A, k0, l0, r, scr, lane); continue; } r -= c0;
        if (r < c1) { cvt_do(A, k1, l1, r, scr, lane); continue; } r -= c1;
        if (r < c2) { cvt_do(A, k2, l2, r, scr, lane); continue; } r -= c2;
        cvt_do(A, k3, l3, r, scr, lane);
    }
}

constexpr int VS_STRIDE = 66;
constexpr int ZE = 1536;
template <int WIN> __device__ __forceinline__ void pool_rows(const bf16* Z, bf16* MIX, const float* hist, float* pout, int rbase, int tfirst, int lr0, int colx, bool sample, bool lastchunk) {
    v4u x[WIN + 7];
#pragma unroll
    for (int k = 0; k < WIN + 7; ++k) { const int t = tfirst - WIN + 1 + k;
        if (t >= 0) x[k] = *(const v4u*)(Z + (size_t)(rbase + t) * ZE + 1024 + colx);
        else if (sample) { const float* hp = hist + (size_t)(15 + t) * 512; x[k] = pack8(*(const f32x4*)hp, *(const f32x4*)(hp + 4)); }
        else x[k] = (v4u){0u, 0u, 0u, 0u}; }
    f32x4 s0 = (f32x4){0.f, 0.f, 0.f, 0.f}, s1 = s0;
#pragma unroll
    for (int k = 0; k < WIN; ++k) { f32x4 a, b; unpack8(x[k], a, b); s0 += a; s1 += b; }
#pragma unroll
    for (int i = 0; i < 8; ++i) {
        const int t = tfirst + i; f32x4 xa, xb; unpack8(x[WIN - 1 + i], xa, xb);
        const int cnti = sample ? WIN : (t + 1 < WIN ? t + 1 : WIN);
        const float inv = 1.0f / (float)cnti;
        st_wt16(MIX + (size_t)(rbase + t) * D + 512 + colx, pack8(s0 * inv - xa, s1 * inv - xb));
        if (lastchunk && lr0 + i >= 49) { float* po = pout + (size_t)(lr0 + i - 49) * 512; *(f32x4*)po = xa; *(f32x4*)(po + 4) = xb; }
        if (i < 7) { f32x4 na, nb, oa, ob; unpack8(x[WIN + i], na, nb); unpack8(x[i], oa, ob); s0 += na - oa; s1 += nb - ob; }
    }
}
__device__ __forceinline__ void even_unit(CArgs A, int ie, int q, LAS unsigned char* lds, int tid, int wave, int lane) {
    const bf16* Z = (const bf16*)(A->ws + WS_Z); bf16* MIX = (bf16*)(A->ws + WS_MIX); const float* VST = (const float*)(A->ws + WS_VST);
    const int row0 = q * 64; const bool sample = row0 >= MP;
    int t0, half, seq;
    if (!sample) { t0 = row0 & (SEQ - 1); half = (t0 >> 6) & 1; seq = row0 >> 13; } else { t0 = 0; half = 0; seq = (row0 - MP) >> 6; }
    const int nj = 64 * (half + 1), jrow0 = row0 - 64 * half, ioff = 64 * half;
    LAS f32x2* stat = (LAS f32x2*)(lds + 8 * 128 * VS_STRIDE * 2);
    LAS bf16* Vs = (LAS bf16*)lds + wave * 128 * VS_STRIDE;
    __syncthreads();
    if (tid < nj) {
        const float* vp = VST + (size_t)(jrow0 + tid) * 16;
        const f32x4 p0 = *(const f32x4*)vp, p1 = *(const f32x4*)(vp + 4), p2 = *(const f32x4*)(vp + 8), p3 = *(const f32x4*)(vp + 12);
        const float s = ((p0[0] + p0[2]) + (p1[0] + p1[2])) + ((p2[0] + p2[2]) + (p3[0] + p3[2])), qq = ((p0[1] + p0[3]) + (p1[1] + p1[3])) + ((p2[1] + p2[3]) + (p3[1] + p3[3]));
        const float mean = s * (1.0f / 512.0f), var = fmaxf(qq * (1.0f / 512.0f) - mean * mean, 0.f);
        stat[tid] = (f32x2){mean, __builtin_amdgcn_rsqf(var + EPS)};
    }
    __syncthreads();
    const int h = wave;
    {
        const int c8 = (lane & 7) * 8;
        const float* gp = A->in[12] + ie * 512 + h * 64 + c8; const float* bp = A->in[13] + ie * 512 + h * 64 + c8;
        const f32x4 g0 = *(const f32x4*)gp, g1 = *(const f32x4*)(gp + 4), b0 = *(const f32x4*)bp, b1 = *(const f32x4*)(bp + 4);
        for (int bb = 0; bb < nj / 64; ++bb) {
            v4u w[8];
#pragma unroll
            for (int i = 0; i < 8; ++i) w[i] = *(const v4u*)(Z + (size_t)(jrow0 + bb * 64 + i * 8 + (lane >> 3)) * ZE + 512 + h * 64 + c8);
#pragma unroll
            for (int i = 0; i < 8; ++i) {
                const int r = bb * 64 + i * 8 + (lane >> 3); f32x4 a, b; unpack8(w[i], a, b);
                const f32x2 st = stat[r];
                a = (a - st.x) * st.y * g0 + b0; b = (b - st.x) * st.y * g1 + b1;
                const v4u o = pack8(a, b);
                LAS unsigned* dst = (LAS unsigned*)(Vs + r * VS_STRIDE + c8);
                dst[0] = o.x; dst[1] = o.y; dst[2] = o.z; dst[3] = o.w;
                if (sample) { float* vo = A->out + O_AV_S + ((size_t)(ie * 32 + seq) * 64 + r) * 512 + h * 64 + c8; *(f32x4*)vo = a; *(f32x4*)(vo + 4) = b; }
            }
        }
    }
    asm volatile("s_waitcnt lgkmcnt(0)" ::: "memory");
    {
        const int fr = lane & 15, fq = lane >> 4;
        f32x4 acc[4][4];
#pragma unroll
        for (int a = 0; a < 4; ++a)
#pragma unroll
            for (int b = 0; b < 4; ++b) acc[a][b] = (f32x4){0.f, 0.f, 0.f, 0.f};
        const float* Wh = A->in[10] + ((size_t)(ie * 8 + h) * 128 + ioff) * 128 + (size_t)fr * 128 + 8 * fq;
        v2u uw[4][4]; float bias[4];
#pragma unroll
        for (int it = 0; it < 4; ++it) { bias[it] = A->in[11][(ie * 8 + h) * 128 + ioff + it * 16 + fr];
#pragma unroll
            for (int ct = 0; ct < 4; ++ct) uw[it][ct] = *(const v2u*)(Z + (size_t)(row0 + it * 16 + fr) * ZE + h * 64 + ct * 16 + 4 * fq); }
        f32x4 wn[4][2];
#pragma unroll
        for (int it = 0; it < 4; ++it) { wn[it][0] = *(const f32x4*)(Wh + it * 16 * 128); wn[it][1] = *(const f32x4*)(Wh + it * 16 * 128 + 4); }
        const int nks = nj / 32;
        for (int ks = 0; ks < nks; ++ks) {
            bf16x8 av[4], bv[4];
#pragma unroll
            for (int it = 0; it < 4; ++it) { const v4u pk = pack8(wn[it][0], wn[it][1]); bv[it] = __builtin_bit_cast(bf16x8, pk); }
            if (ks + 1 < nks) {
#pragma unroll
                for (int it = 0; it < 4; ++it) { wn[it][0] = *(const f32x4*)(Wh + it * 16 * 128 + (ks + 1) * 32); wn[it][1] = *(const f32x4*)(Wh + it * 16 * 128 + (ks + 1) * 32 + 4); } }
#pragma unroll
            for (int ct = 0; ct < 4; ++ct) {
                const LAS bf16* p = Vs + (ks * 32 + 8 * fq) * VS_STRIDE + ct * 16 + fr;
#pragma unroll
                for (int e = 0; e < 8; ++e) av[ct][e] = (short)p[e * VS_STRIDE];
            }
#pragma unroll
            for (int ct = 0; ct < 4; ++ct)
#pragma unroll
                for (int it = 0; it < 4; ++it) acc[ct][it] = __builtin_amdgcn_mfma_f32_16x16x32_bf16(av[ct], bv[it], acc[ct][it], 0, 0, 0);
        }
#pragma unroll
        for (int it = 0; it < 4; ++it) {
            const int row = row0 + it * 16 + fr;
#pragma unroll
            for (int ct = 0; ct < 4; ++ct) {
                const int col = h * 64 + ct * 16 + 4 * fq;
                const f32x4 uu = (f32x4){bflo(uw[it][ct].x), bfhi(uw[it][ct].x), bflo(uw[it][ct].y), bfhi(uw[it][ct].y)};
                const f32x4 y = uu * (acc[ct][it] + bias[it]);
                v2u o; o.x = pk2(y[0], y[1]); o.y = pk2(y[2], y[3]);
                st_wt8(MIX + (size_t)row * D + col, o);
            }
        }
    }
    {
        const int g = wave & 3, rh = wave >> 2, cb = lane & 15, rs = lane >> 4;
        const int colx = g * 128 + cb * 8;
        const int rbase = row0 - t0;
        const bool lastchunk = sample || (t0 == SEQ - 64);
        const float* hist = A->in[2] + ((size_t)(ie * 32 + seq) * 15) * 512 + colx;
        float* pout = sample ? (A->out + O_POOL_S + ((size_t)(ie * 32 + seq) * 15) * 512 + colx) : (A->out + O_POOL_P + ((size_t)(ie * 2 + seq) * 15) * 512 + colx);
        const int lr0 = 32 * rh + 8 * rs, tfirst = t0 + lr0;
        if (g == 0) pool_rows<2>(Z, MIX, hist, pout, rbase, tfirst, lr0, colx, sample, lastchunk);
        else if (g == 1) pool_rows<4>(Z, MIX, hist, pout, rbase, tfirst, lr0, colx, sample, lastchunk);
        else if (g == 2) pool_rows<8>(Z, MIX, hist, pout, rbase, tfirst, lr0, colx, sample, lastchunk);
        else pool_rows<16>(Z, MIX, hist, pout, rbase, tfirst, lr0, colx, sample, lastchunk);
    }
}

__device__ __forceinline__ void odd_unit(CArgs A, int io, int q, LAS unsigned char* lds, int tid, int wave, int lane) {
    const bf16* Z = (const bf16*)(A->ws + WS_Z); bf16* MIX = (bf16*)(A->ws + WS_MIX);
    const int row0 = q * 64; const bool sample = row0 >= MP;
    int t0, seq;
    if (!sample) { t0 = row0 & (SEQ - 1); seq = row0 >> 13; } else { t0 = 0; seq = (row0 - MP) >> 6; }
    const int rbase = row0 - t0; const int T = sample ? 64 : SEQ; const bool lastchunk = sample || (t0 == SEQ - 64);
    LAS bf16* cin = (LAS bf16*)lds;
    LAS float* cbuf = (LAS float*)(lds + 94 * 1024);
    {
        const int cb = tid & 63, rg = tid >> 6, ch = cb * 8;
        const float* dw = A->in[22] + (size_t)io * 3 * 512 + ch;
        const f32x4 w0a = *(const f32x4*)dw, w0b = *(const f32x4*)(dw + 4), w1a = *(const f32x4*)(dw + 512), w1b = *(const f32x4*)(dw + 516), w2a = *(const f32x4*)(dw + 1024), w2b = *(const f32x4*)(dw + 1028);
        const float* hd = A->in[4] + ((size_t)(io * 32 + seq) * 2) * 512 + ch;
        float* dout = sample ? (A->out + O_CD_S + ((size_t)(io * 32 + seq) * 2) * 512 + ch) : (A->out + O_CD_P + ((size_t)(io * 2 + seq) * 2) * 512 + ch);
        const int tf = t0 + 8 * rg;
        v4u dgw[10], gbw[8];
#pragma unroll
        for (int k = 0; k < 10; ++k) { const int t = tf - 2 + k;
            if (t >= 0) dgw[k] = *(const v4u*)(Z + (size_t)(rbase + t) * ZE + 1024 + ch);
            else if (sample) { const float* hp = hd + (size_t)(2 + t) * 512; dgw[k] = pack8(*(const f32x4*)hp, *(const f32x4*)(hp + 4)); }
            else dgw[k] = (v4u){0u, 0u, 0u, 0u}; }
#pragma unroll
        for (int i = 0; i < 8; ++i) gbw[i] = *(const v4u*)(Z + (size_t)(rbase + tf + i) * ZE + 512 + ch);
        f32x4 m2a, m2b, m1a, m1b; unpack8(dgw[0], m2a, m2b); unpack8(dgw[1], m1a, m1b);
#pragma unroll
        for (int i = 0; i < 8; ++i) {
            const int t = tf + i; f32x4 da, db, ga, gb; unpack8(dgw[2 + i], da, db); unpack8(gbw[i], ga, gb);
            const f32x4 ya = ga * (w0a * m2a + w1a * m1a + w2a * da), yb = gb * (w0b * m2b + w1b * m1b + w2b * db);
            st_wt16(MIX + (size_t)(rbase + t) * D + 512 + ch, pack8(ya, yb));
            const int lr = 8 * rg + i;
            if (lastchunk && lr >= 62) { float* po = dout + (size_t)(lr - 62) * 512; *(f32x4*)po = da; *(f32x4*)(po + 4) = db; }
            m2a = m1a; m2b = m1b; m1a = da; m1b = db;
        }
    }
    __syncthreads();
    {
        const float* hc = A->in[3] + ((size_t)(io * 32 + seq) * 30) * 512;
        float* cout = sample ? (A->out + O_CC_S + ((size_t)(io * 32 + seq) * 30) * 512) : (A->out + O_CC_P + ((size_t)(io * 2 + seq) * 30) * 512);
        for (int base = tid; base < 94 * 64; base += 4 * NTHR) {
            v4u w[4];
#pragma unroll
            for (int u = 0; u < 4; ++u) { const int item = base + u * NTHR, lr = item >> 6, cb = item & 63, t = t0 + lr - 30;
                if (item < 94 * 64 && t >= 0) w[u] = *(const v4u*)(Z + (size_t)(rbase + t) * ZE + cb * 8);
                else if (item < 94 * 64 && sample) { const float* hp = hc + (size_t)(30 + t) * 512 + cb * 8; w[u] = pack8(*(const f32x4*)hp, *(const f32x4*)(hp + 4)); }
                else w[u] = (v4u){0u, 0u, 0u, 0u}; }
#pragma unroll
            for (int u = 0; u < 4; ++u) { const int item = base + u * NTHR, lr = item >> 6, cb = item & 63, t = t0 + lr - 30;
                if (item < 94 * 64) {
                    *(LAS v4u*)(cin + lr * 512 + cb * 8) = w[u];
                    if (lastchunk && lr >= 30 && t >= T - 30) { f32x4 a, b; unpack8(w[u], a, b); float* po = cout + (size_t)(t - (T - 30)) * 512 + cb * 8; *(f32x4*)po = a; *(f32x4*)(po + 4) = b; } } }
        }
    }
    __syncthreads();
    {
        const int cp = tid & 255, rq = tid >> 8;
        f32x2 w[31];
#pragma unroll
        for (int k = 0; k < 31; ++k) w[k] = *(const f32x2*)(A->in[18] + ((size_t)io * 31 + k) * 512 + 2 * cp);
        const f32x2 cbias = *(const f32x2*)(A->in[19] + io * 512 + 2 * cp);
        const float* lg = A->in[20] + io * 512 + lane * 8; const float* lb = A->in[21] + io * 512 + lane * 8;
        const f32x4 g0 = *(const f32x4*)lg, g1 = *(const f32x4*)(lg + 4), b0 = *(const f32x4*)lb, b1 = *(const f32x4*)(lb + 4);
        for (int sb = 0; sb < 4; ++sb) {
            const int r0 = 16 * sb + 8 * rq;
            f32x2 acc[8];
#pragma unroll
            for (int i = 0; i < 8; ++i) acc[i] = cbias;
#pragma unroll
            for (int j = 0; j < 38; ++j) { const unsigned xw = *(const LAS unsigned*)(cin + (r0 + j) * 512 + 2 * cp); const f32x2 x = (f32x2){bflo(xw), bfhi(xw)};
#pragma unroll
                for (int i = 0; i < 8; ++i) { if (j - i >= 0 && j - i < 31) acc[i] += w[j - i] * x; } }
#pragma unroll
            for (int i = 0; i < 8; ++i) *(LAS f32x2*)(cbuf + (8 * rq + i) * 512 + 2 * cp) = acc[i];
            __syncthreads();
#pragma unroll
            for (int rr = 0; rr < 2; ++rr) {
                const int lr = 2 * wave + rr;
                f32x4 a = *(const LAS f32x4*)(cbuf + lr * 512 + lane * 8), b = *(const LAS f32x4*)(cbuf + lr * 512 + lane * 8 + 4);
                const float s = wave_sum((a[0] + a[1]) + (a[2] + a[3]) + (b[0] + b[1]) + (b[2] + b[3]));
                const float mean = s * (1.0f / 512.0f);
                a = a - mean; b = b - mean;
                const float qq = wave_sum((a[0] * a[0] + a[1] * a[1]) + (a[2] * a[2] + a[3] * a[3]) + (b[0] * b[0] + b[1] * b[1]) + (b[2] * b[2] + b[3] * b[3]));
                const float rstd = __builtin_amdgcn_rsqf(qq * (1.0f / 512.0f) + EPS);
                a = a * rstd * g0 + b0; b = b * rstd * g1 + b1;
#pragma unroll
                for (int e = 0; e < 4; ++e) { a[e] = a[e] * sigmoidf_(a[e]); b[e] = b[e] * sigmoidf_(b[e]); }
                st_wt16(MIX + (size_t)(row0 + 16 * sb + lr) * D + lane * 8, pack8(a, b));
            }
            __syncthreads();
        }
    }
}

#define RLX_AGENT __ATOMIC_RELAXED, __HIP_MEMORY_SCOPE_AGENT
#define XB_TMO      128
#define XB_XCNT(j)  (256  + 64 * (j))
#define XB_XSUB(j)  (1280 + 64 * (j))
#define XB_XGEN(j)  (2304 + 64 * (j))
#define XB_TOP      3328
#define XB_TOPGEN   3392
#define XCD_BAR_WORDS 3456
#define XB_SPIN_CAP (1u << 18)

__device__ __forceinline__ unsigned xb_ld(unsigned* p)              { return __hip_atomic_load(p, __ATOMIC_RELAXED, __HIP_MEMORY_SCOPE_AGENT); }
__device__ __forceinline__ unsigned xb_add(unsigned* p, unsigned v) { return __hip_atomic_fetch_add(p, v, __ATOMIC_RELAXED, __HIP_MEMORY_SCOPE_AGENT); }
__device__ __forceinline__ unsigned xb_xcc_id() { return (unsigned)__builtin_amdgcn_s_getreg((3 << 11) | 20) & 0xFu; }
#define XB_SPIN(cond, bar) do { unsigned _sp = 0; while (cond) { __builtin_amdgcn_s_sleep(1); \
    if ((++_sp & 255u) == 0u) { if (xb_ld(&(bar)[XB_TMO])) break; if (_sp > XB_SPIN_CAP) { atomicAdd(&(bar)[XB_TMO], 1u); break; } } } } while (0)

struct XcdBarrier {
    unsigned* bar; unsigned x;
    volatile LAS unsigned* st;
};

__device__ __forceinline__ XcdBarrier xcd_barrier_post(unsigned* bar, volatile LAS unsigned* st) {
    XcdBarrier b; b.bar = bar; b.x = xb_xcc_id(); b.st = st;
    if (threadIdx.x == 0) (void)xb_add(&bar[XB_XCNT(b.x)], 1u);
    return b;
}
__device__ __forceinline__ void xcd_barrier_complete(unsigned* bar, unsigned x, unsigned& nloc, unsigned& nx) {
    const unsigned G = gridDim.x * gridDim.y * gridDim.z;
    unsigned sum, cnt, mine, sp = 0u;
    for (;;) {
        sum = 0u; cnt = 0u; mine = 0u;
#pragma unroll
        for (unsigned j = 0; j < 16; ++j) { const unsigned c = xb_ld(&bar[XB_XCNT(j)]); sum += c; cnt += (c > 0u) ? 1u : 0u; mine = (j == x) ? c : mine; }
        if (sum == G) break;
        __builtin_amdgcn_s_sleep(1);
        if ((++sp & 255u) == 0u) { if (xb_ld(&bar[XB_TMO])) break; if (sp > XB_SPIN_CAP) { atomicAdd(&bar[XB_TMO], 1u); break; } }
    }
    nloc = mine > 0u ? mine : 1u; nx = cnt > 0u ? cnt : 1u;
}

__device__ __forceinline__ void xcd_barrier(const XcdBarrier& b) {
    asm volatile("s_waitcnt vmcnt(0)" ::: "memory");
    __syncthreads();
    if (threadIdx.x == 0) {
        unsigned* bar = b.bar;
        __builtin_amdgcn_s_waitcnt(0);
        unsigned nloc = b.st[0], nx = b.st[1];
        if (nloc == 0u) { xcd_barrier_complete(bar, b.x, nloc, nx); b.st[0] = nloc; b.st[1] = nx; }
        const unsigned old = xb_add(&bar[XB_XSUB(b.x)], 1u);
        const unsigned gen = old / nloc;
        if (old + 1u == (gen + 1u) * nloc) {
            __builtin_amdgcn_fence(__ATOMIC_RELEASE, "agent");
            asm volatile("s_waitcnt vmcnt(0)" ::: "memory");
            const unsigned og = xb_add(&bar[XB_TOP], 1u);
            const unsigned tg = og / nx;
            if (og + 1u == (tg + 1u) * nx) xb_add(&bar[XB_TOPGEN], 1u);
            else XB_SPIN(xb_ld(&bar[XB_TOPGEN]) == tg, bar);
            __builtin_amdgcn_fence(__ATOMIC_ACQUIRE, "agent");
            xb_add(&bar[XB_XGEN(b.x)], 1u);
            asm volatile("s_waitcnt vmcnt(0)" ::: "memory");
        } else {
            XB_SPIN(xb_ld(&bar[XB_XGEN(b.x)]) == gen, bar);
            __builtin_amdgcn_fence(__ATOMIC_ACQUIRE, "agent");
            asm volatile("s_waitcnt vmcnt(0)" ::: "memory");
        }
    }
    __syncthreads();
}

__global__ void __launch_bounds__(NTHR, 2) fwd_megakernel(Args A_unused) {
    extern __shared__ __attribute__((aligned(16))) unsigned char lds_raw[];
    LAS unsigned char* lds = (LAS unsigned char*)lds_raw;
    cg::grid_group grid = cg::this_grid();
    const CArgs A0 = (CArgs)__builtin_amdgcn_kernarg_segment_ptr();
    const int G = gridDim.x, bx = blockIdx.x;
    volatile LAS unsigned* xst = (volatile LAS unsigned*)(lds + LDS_BYTES - 64);
    if (threadIdx.x < 2) xst[threadIdx.x] = 0u;
    __syncthreads();
    const XcdBarrier xbar = xcd_barrier_post((unsigned*)(A0->ws + WS_BAR), xst);
#define GRID_SYNC1() xcd_barrier(xbar)
#define GRID_SYNC_CG() do { asm volatile("s_waitcnt vmcnt(0) lgkmcnt(0)" ::: "memory"); grid.sync(); } while (0)
#if PROBE_SYNC2
#define GRID_SYNC() do { GRID_SYNC1(); GRID_SYNC1(); } while (0)
#else
#define GRID_SYNC() GRID_SYNC1()
#endif
#define GRID_SYNC_UNUSED() do { } while (0)
#define PHASE_BEGIN() CArgs A = A0; LAUNDER_S(A); int tid = threadIdx.x; LAUNDER_V(tid); const int lane = tid & 63, wave = __builtin_amdgcn_readfirstlane(tid >> 6); const int gw = bx * NWAVES + wave, NGW = G * NWAVES; \
    unsigned char* ws = A->ws; float* X = A->out + O_Y; float* SS = (float*)(ws + WS_SS); bf16* XB = (bf16*)(ws + WS_XB); (void)lane; (void)gw; (void)NGW; (void)X; (void)SS; (void)XB

    {
        PHASE_BEGIN();
        cvt_run(A, 2, 0, 0, 1, 0, 0, 0, 0, 0, lds, gw, NGW, wave, lane);
        for (int m0 = gw; m0 < M; m0 += 3 * NGW) {
            f32x4 v[3][4];
#pragma unroll
            for (int r = 0; r < 3; ++r) { const int m = m0 + r * NGW; if (m < M) { const float* src = (m < MP) ? (A->in[0] + (size_t)m * D) : (A->in[1] + (size_t)(m - MP) * D);
#pragma unroll
                for (int j = 0; j < 4; ++j) v[r][j] = *(const f32x4*)(src + (lane + 64 * j) * 4); } }
#pragma unroll
            for (int r = 0; r < 3; ++r) { const int m = m0 + r * NGW; if (m < M) { float s2 = 0.f;
#pragma unroll
                for (int j = 0; j < 4; ++j) { s2 += (v[r][j][0] * v[r][j][0] + v[r][j][1] * v[r][j][1]) + (v[r][j][2] * v[r][j][2] + v[r][j][3] * v[r][j][3]);
                    v2u o; o.x = pk2(v[r][j][0], v[r][j][1]); o.y = pk2(v[r][j][2], v[r][j][3]); *(v2u*)(XB + (size_t)m * D + (lane + 64 * j) * 4) = o; }
                s2 = wave_sum(s2);
                if (lane < 4) *(f32x4*)(SS + (size_t)m * 16 + lane * 4) = (f32x4){lane == 0 ? s2 : 0.f, 0.f, 0.f, 0.f}; } }
        }
    }
    GRID_SYNC_CG();

#pragma unroll 1
    for (int layer = 0; layer < 4; ++layer) {
        const int i2 = layer >> 1; const bool odd = layer & 1;
#pragma unroll 1
        for (int rep = 0; rep < 1 + PROBE_IN2; ++rep) {
        if (!odd) { PHASE_BEGIN(); pg8::Gemm g{XB, (const bf16*)(ws + WS_WIN), M, EVEN_IN, D}; pg8::StaticOrderT<6> S; S.init(D, G, bx);
            pg8::EpiAct<0> E{(bf16*)(ws + WS_Z), EVEN_IN, SS + (size_t)(2 * layer) * M * 16, (float*)(ws + WS_VST)};
            pg8::gemm_phase<pg8::EpiAct<0>, pg8::StaticOrderT<6>, true, true>(lds, g, S, E, tid); }
        else { PHASE_BEGIN(); pg8::Gemm g{XB, (const bf16*)(ws + WS_WIN), M, ODD_IN, D}; pg8::StaticOrderT<10> S; S.init(D, G, bx);
            pg8::EpiOdd E{(bf16*)(ws + WS_Z), SS + (size_t)(2 * layer) * M * 16};
            pg8::gemm_phase<pg8::EpiOdd, pg8::StaticOrderT<10>, true, true>(lds, g, S, E, tid); } }
        GRID_SYNC();
#pragma unroll 1
        for (int rep = 0; rep < 1 + PROBE_MIX2; ++rep) {
        { PHASE_BEGIN(); unsigned* rdy = (unsigned*)(ws + WS_RDY) + layer * 72; const int nu = M / 64;
          for (int k = 0; k < 2; ++k) { int q;
              if (G == 256) { if (k == 0) q = bx + 32; else { if (bx < 224) break; q = bx - 224; } }
              else { q = bx + k * G; if (k == 1) { for (int q2 = q; q2 < nu; q2 += G) { if (!odd) even_unit(A, i2, q2, lds, tid, wave, lane); else odd_unit(A, i2, q2, lds, tid, wave, lane);
                          asm volatile("s_waitcnt vmcnt(0)" ::: "memory"); __syncthreads(); if (tid == 0) __hip_atomic_fetch_add(rdy + (q2 >> 2), 1u, __ATOMIC_RELAXED, __HIP_MEMORY_SCOPE_AGENT); } break; } if (q >= nu) break; }
              if (!odd) even_unit(A, i2, q, lds, tid, wave, lane); else odd_unit(A, i2, q, lds, tid, wave, lane);
              asm volatile("s_waitcnt vmcnt(0)" ::: "memory"); __syncthreads();
              if (tid == 0) __hip_atomic_fetch_add(rdy + (q >> 2), 1u, __ATOMIC_RELAXED, __HIP_MEMORY_SCOPE_AGENT); } }
        __syncthreads(); }
#pragma unroll 1
        for (int rep = 0; rep < 1 + PROBE_CVT2; ++rep)
        { PHASE_BEGIN();
          const bool skew = (G == 256); const int cng = skew ? NGW - 32 * NWAVES : NGW;
          if ((!skew || bx < 224) && layer == 0) cvt_run(A, 1, 2, 0, 0, 0, 0, 0, 0, 0, lds, gw, cng, wave, lane); }
        if (G != 256) GRID_SYNC();
#pragma unroll 1
        for (int rep = 0; rep < 1 + PROBE_OUT2; ++rep)
        { PHASE_BEGIN(); pg8::Gemm g{(const bf16*)(ws + WS_MIX), (const bf16*)(ws + WS_WOUT + (size_t)(layer & 1) * 2 * MiB), M, D, D}; pg8::EpiRes E{X, ws, 2 * layer};
#if PROBE_OUT2 || PROBE_FF2X2
          E.dry = rep < PROBE_OUT2;
#endif

          if (G == 256) { pg8::Counted<pg8::TailOrder256> S; S.init(D, G, bx); S.ready = (const unsigned*)(ws + WS_RDY) + layer * 72; S.need = 4u;
              pg8::gemm_phase<pg8::EpiRes, pg8::Counted<pg8::TailOrder256>, true, true>(lds, g, S, E, tid); }
          else { pg8::StaticOrderT<4> S; S.init(D, G, bx); pg8::gemm_phase<pg8::EpiRes, pg8::StaticOrderT<4>, true, true>(lds, g, S, E, tid); } }
        { PHASE_BEGIN();
          if (G == 256 && bx >= 128) pg8::tail_job(X, ws, 2 * layer, (bx - 128) * NWAVES + wave, lane);
          const bool skew = (G == 256); const int cgw = skew ? gw - 128 * NWAVES : gw, cng = skew ? NGW - 128 * NWAVES : NGW;
          if (cgw >= 0) { if (layer < 3) cvt_run(A, 2, 3, layer, 0, layer + 1, 0, 0, 0, 0, lds, cgw, cng, wave, lane); else cvt_run(A, 1, 3, layer, 0, 0, 0, 0, 0, 0, lds, cgw, cng, wave, lane); } }
        GRID_SYNC();
#pragma unroll 1
        for (int rep = 0; rep < 1 + PROBE_FF1X2; ++rep)
        { PHASE_BEGIN(); pg8::Gemm g{XB, (const bf16*)(ws + WS_WFF1), M, FF, D}; pg8::StaticOrderT<16> S; S.init(D, G, bx);
          pg8::EpiAct<2> E{(bf16*)(ws + WS_H), FF, SS + (size_t)(2 * layer + 1) * M * 16, nullptr};
          pg8::gemm_phase<pg8::EpiAct<2>, pg8::StaticOrderT<16>, true, true>(lds, g, S, E, tid); }
        GRID_SYNC();
#pragma unroll 1
        for (int rep = 0; rep < 1 + PROBE_FF2X2; ++rep)
        { PHASE_BEGIN(); pg8::Gemm g{(const bf16*)(ws + WS_H), (const bf16*)(ws + WS_WFF2), M, D, FF}; pg8::EpiRes E{X, ws, 2 * layer + 1};
#if PROBE_OUT2 || PROBE_FF2X2
          E.dry = rep < PROBE_FF2X2;
#endif

          if (G == 256) { pg8::TailOrder256 S; S.init(FF, G, bx); pg8::gemm_phase<pg8::EpiRes, pg8::TailOrder256, true, true>(lds, g, S, E, tid); }
          else { pg8::StaticOrderT<4> S; S.init(FF, G, bx); pg8::gemm_phase<pg8::EpiRes, pg8::StaticOrderT<4>, true, true>(lds, g, S, E, tid); } }
        { PHASE_BEGIN(); if (G == 256 && bx >= 128) pg8::tail_job(X, ws, 2 * layer + 1, (bx - 128) * NWAVES + wave, lane); }
        if (layer < 3) { PHASE_BEGIN();
          const bool skew = (G == 256); const int cgw = skew ? gw - 128 * NWAVES : gw, cng = skew ? NGW - 128 * NWAVES : NGW;
          if (cgw >= 0) cvt_run(A, 2, 1, layer + 1, 2, layer + 1, 0, 0, 0, 0, lds, cgw, cng, wave, lane); }
        GRID_SYNC();
    }
    {
        PHASE_BEGIN();
        const float* fg = A->in[7]; const float* ss = SS + (size_t)8 * M * 16;
        f32x4 gv[4];
#pragma unroll
        for (int j = 0; j < 4; ++j) gv[j] = *(const f32x4*)(fg + (lane + 64 * j) * 4);
#if RES_LO
        const bf16* XL = (const bf16*)X;
        for (int m = gw; m < M; m += NGW) {
            const float spv = lane < 16 ? ss[(size_t)m * 16 + lane] : 0.f;
            v2u h[4], l[4];
#pragma unroll
            for (int j = 0; j < 4; ++j) { h[j] = *(const v2u*)(XB + (size_t)m * D + (lane + 64 * j) * 4); l[j] = *(const v2u*)(XL + (size_t)m * 2048 + 1024 + (lane + 64 * j) * 4); }
            const float rs = __builtin_amdgcn_rsqf(wave_sum(spv) * (1.0f / 1024.0f) + EPS);
            asm volatile("s_waitcnt vmcnt(0)" ::: "memory");
#pragma unroll
            for (int j = 0; j < 4; ++j) { const f32x4 x = (f32x4){bflo(h[j].x) + bflo(l[j].x), bfhi(h[j].x) + bfhi(l[j].x), bflo(h[j].y) + bflo(l[j].y), bfhi(h[j].y) + bfhi(l[j].y)};
                *(f32x4*)(X + (size_t)m * D + (lane + 64 * j) * 4) = x * rs * gv[j]; }
        }
#else
        for (int m0 = gw; m0 < M; m0 += 3 * NGW) {
            v2u h[3][4]; float spv[3];
#pragma unroll
            for (int r = 0; r < 3; ++r) { const int m = m0 + r * NGW; if (m < M) { spv[r] = lane < 16 ? ss[(size_t)m * 16 + lane] : 0.f;
#pragma unroll
                for (int j = 0; j < 4; ++j) h[r][j] = *(const v2u*)(XB + (size_t)m * D + (lane + 64 * j) * 4); } }
#pragma unroll
            for (int r = 0; r < 3; ++r) { const int m = m0 + r * NGW; if (m < M) { const float rs = __builtin_amdgcn_rsqf(wave_sum(spv[r]) * (1.0f / 1024.0f) + EPS);
#pragma unroll
                for (int j = 0; j < 4; ++j) { const f32x4 x = (f32x4){bflo(h[r][j].x), bfhi(h[r][j].x), bflo(h[r][j].y), bfhi(h[r][j].y)};
                    *(f32x4*)(X + (size_t)m * D + (lane + 64 * j) * 4) = x * rs * gv[j]; } } }
        }
#endif
    }
}

extern "C" void kernel_launch(void* const* d_in, const int* in_sizes, int n_in, void* d_out, int out_size, void* d_ws, size_t ws_size, hipStream_t stream) {
    static int grid = 0;
    if (grid == 0) {
        if (n_in != 25 || (size_t)out_size != O_END || ws_size < WS_END) { fprintf(stderr, "kernel_launch: unexpected shapes (n_in %d out %d ws %zu)\n", n_in, out_size, ws_size); grid = -1; return; }
        int dev = 0, cus = 0, per_cu = 0;
        (void)hipGetDevice(&dev); (void)hipDeviceGetAttribute(&cus, hipDeviceAttributeMultiprocessorCount, dev);
        (void)hipFuncSetAttribute((const void*)fwd_megakernel, hipFuncAttributeMaxDynamicSharedMemorySize, LDS_BYTES);
        (void)hipOccupancyMaxActiveBlocksPerMultiprocessor(&per_cu, (const void*)fwd_megakernel, NTHR, LDS_BYTES);
        (void)hipGetLastError();
        if (per_cu < 1) per_cu = 1;
        grid = cus * per_cu;
        fprintf(stderr, "kernel_launch: cus %d per_cu %d grid %d ws %zu\n", cus, per_cu, grid, ws_size);
    }
    if (grid < 0) return;
    (void)hipMemsetAsync((unsigned char*)d_ws + WS_CNT, 0, ZERO_BYTES, stream);
    Args a{};
    for (int i = 0; i < 25; ++i) a.in[i] = (const float*)d_in[i];
    a.out = (float*)d_out; a.ws = (unsigned char*)d_ws;
    void* args[] = {&a};
    hipError_t e = hipLaunchCooperativeKernel((const void*)fwd_megakernel, dim3(grid), dim3(NTHR), args, LDS_BYTES, stream);
    if (e != hipSuccess) fprintf(stderr, "cooperative launch failed: %s (grid %d)\n", hipGetErrorString(e), grid);
}
```
